# Optimizing an MI355X kernel written in HIP

```python
import math
import jax, jax.numpy as jnp
from jax import lax
import numpy as np

D_MODEL = 2048
BATCH = 4
SEQ = 4096
DEPTH = 2

CHUNK = 64
Q_BLOCK = 128
MLA_HEADS = 8
MLA_Q_LORA = 512
MLA_KV_LORA = 256
MLA_NOPE_DIM = 128
MLA_ROPE_DIM = 64
MLA_V_DIM = 128
RET_HEADS = 4
RET_QK_DIM = 256
RET_V_DIM = 256
MIX_WIDTH = MLA_HEADS * MLA_V_DIM + RET_HEADS * RET_V_DIM
D_FF = -(-(8 * D_MODEL) // (3 * 256)) * 256
ROPE_THETA = 10000.0
LN_EPS = 1e-5
RMS_EPS = 1e-6
GN_EPS = 1e-5
ALPHA = (2 * DEPTH) ** 0.25
BETA = (8 * DEPTH) ** -0.25
IN_SIZES = (MLA_Q_LORA, MLA_KV_LORA, MLA_ROPE_DIM,
            RET_HEADS * RET_QK_DIM, RET_HEADS * RET_QK_DIM,
            RET_HEADS * RET_V_DIM, RET_HEADS * RET_V_DIM)
D_IN = sum(IN_SIZES)

kernel_name = "hybrid_mla_retention_deepnorm"


def layer_norm(x, g, b):
    xf = x.astype(jnp.float32)
    mu = xf.mean(-1, keepdims=True)
    var = jnp.square(xf - mu).mean(-1, keepdims=True)
    return ((xf - mu) * lax.rsqrt(var + LN_EPS) * g + b).astype(x.dtype)


def rms_norm(x, g):
    xf = x.astype(jnp.float32)
    return (xf * lax.rsqrt(jnp.square(xf).mean(-1, keepdims=True) + RMS_EPS) * g).astype(x.dtype)


def rope_tables(positions, dim):
    inv_freq = ROPE_THETA ** (-jnp.arange(0, dim, 2, dtype=jnp.float32) / dim)
    ang = positions.astype(jnp.float32)[..., None] * inv_freq
    return jnp.cos(ang), jnp.sin(ang)


def apply_rope(t, cos, sin):
    tf = t.astype(jnp.float32)
    half = t.shape[-1] // 2
    t1, t2 = tf[..., :half], tf[..., half:]
    c, s = cos[:, :, None, :], sin[:, :, None, :]
    return jnp.concatenate([t1 * c - t2 * s, t2 * c + t1 * s], axis=-1).astype(t.dtype)


def split_columns(h):
    parts, start = [], 0
    for size in IN_SIZES:
        parts.append(h[..., start:start + size])
        start += size
    return parts


def mla_group(c_q, c_kv, k_rope, cos, sin, q_norm_g, kv_norm_g, w_uq, w_ukv):
    B, S, _ = c_q.shape
    H = MLA_HEADS
    q = (rms_norm(c_q, q_norm_g) @ w_uq).reshape(B, S, H, MLA_NOPE_DIM + MLA_ROPE_DIM)
    q_nope = q[..., :MLA_NOPE_DIM]
    q_rope = apply_rope(q[..., MLA_NOPE_DIM:], cos, sin)
    kv = (rms_norm(c_kv, kv_norm_g) @ w_ukv).reshape(B, S, H, MLA_NOPE_DIM + MLA_V_DIM)
    k_nope, v = kv[..., :MLA_NOPE_DIM], kv[..., MLA_NOPE_DIM:]
    k_r = apply_rope(k_rope[:, :, None, :], cos, sin)[:, :, 0, :]
    scale = (MLA_NOPE_DIM + MLA_ROPE_DIM) ** -0.5
    chunk_id = jnp.arange(S) // CHUNK
    neg = jnp.finfo(jnp.float32).min
    outs = []
    for blk in range(S // Q_BLOCK):
        q0 = blk * Q_BLOCK
        kend = q0 + Q_BLOCK
        s = (jnp.einsum('bqhd,bkhd->bhqk', q_nope[:, q0:kend], k_nope[:, :kend])
             + jnp.einsum('bqhr,bkr->bhqk', q_rope[:, q0:kend], k_r[:, :kend]))
        s = s.astype(jnp.float32) * scale
        mask = chunk_id[q0:kend, None] >= chunk_id[None, :kend]
        s = jnp.where(mask[None, None], s, neg)
        p = jax.nn.softmax(s, axis=-1).astype(v.dtype)
        outs.append(jnp.einsum('bhqk,bkhd->bqhd', p, v[:, :kend]))
    o = jnp.concatenate(outs, axis=1)
    return o.reshape(B, S, H * MLA_V_DIM)


def retention_group(rq, rk, rv, rg, cos, sin, gn_g, gn_b):
    B, S, _ = rq.shape
    H, DK, DV, L = RET_HEADS, RET_QK_DIM, RET_V_DIM, CHUNK
    NC = S // L
    f32 = jnp.float32
    q = apply_rope(rq.reshape(B, S, H, DK), cos, sin).astype(f32) * (DK ** -0.5)
    k = apply_rope(rk.reshape(B, S, H, DK), cos, sin).astype(f32)
    v = rv.reshape(B, S, H, DV).astype(f32)
    q = q.reshape(B, NC, L, H, DK)
    k = k.reshape(B, NC, L, H, DK)
    v = v.reshape(B, NC, L, H, DV)
    log_gamma = jnp.log1p(-jnp.exp2(-5.0 - jnp.arange(H, dtype=f32)))
    idx = jnp.arange(L, dtype=f32)
    intra_decay = jnp.exp(log_gamma[:, None, None] * jnp.abs(idx[:, None] - idx[None, :]))
    scores = jnp.einsum('bcnhd,bcmhd->bchnm', q, k) * intra_decay[None, None]
    o_intra = jnp.einsum('bchnm,bcmhe->bcnhe', scores, v)
    q_decay = jnp.exp(log_gamma[:, None] * (idx + 1.0))[None]
    k_decay = jnp.exp(log_gamma[:, None] * (L - 1.0 - idx))
    chunk_decay = jnp.exp(log_gamma * L)
    q_decay = q_decay[0]

    def step(state, inp):
        qc, kc, vc = inp
        o_inter = jnp.einsum('bnhd,hn,bhde->bnhe', qc, q_decay, state)
        state = (state * chunk_decay[None, :, None, None]
                 + jnp.einsum('bmhd,hm,bmhe->bhde', kc, k_decay, vc))
        return state, o_inter

    state0 = jnp.zeros((B, H, DK, DV), f32)
    xs = (q.transpose(1, 0, 2, 3, 4), k.transpose(1, 0, 2, 3, 4), v.transpose(1, 0, 2, 3, 4))
    _, o_inter = lax.scan(step, state0, xs)
    o = (o_intra + o_inter.transpose(1, 0, 2, 3, 4)).reshape(B, S, H, DV)
    mu = o.mean(-1, keepdims=True)
    var = jnp.square(o - mu).mean(-1, keepdims=True)
    o = ((o - mu) * lax.rsqrt(var + GN_EPS)).reshape(B, S, H * DV) * gn_g + gn_b
    o = jax.nn.silu(rg.astype(f32)) * o
    return o.astype(rq.dtype)


def setup_inputs(seed: int = 0) -> dict:
    key = jax.random.key(seed)
    ks = list(jax.random.split(key, 24))
    f32 = jnp.float32

    def nrm(k, shape, scale):
        return jax.random.normal(k, shape, f32) * scale

    x = jax.random.normal(ks[0], (BATCH, SEQ, D_MODEL), f32)
    start = jax.random.randint(ks[1], (BATCH, 1), 0, 4096, dtype=jnp.int32)
    positions = (start + jnp.arange(SEQ, dtype=jnp.int32)[None, :]).astype(jnp.int32)
    return {
        "x": x,
        "positions": positions,
        "ln_in_g": 1.0 + nrm(ks[2], (D_MODEL,), 0.02),
        "ln_in_b": nrm(ks[3], (D_MODEL,), 0.02),
        "w_in": nrm(ks[4], (DEPTH, D_MODEL, D_IN), D_MODEL ** -0.5),
        "q_norm_g": 1.0 + nrm(ks[5], (DEPTH, MLA_Q_LORA), 0.02),
        "kv_norm_g": 1.0 + nrm(ks[6], (DEPTH, MLA_KV_LORA), 0.02),
        "w_uq": nrm(ks[7], (DEPTH, MLA_Q_LORA, MLA_HEADS * (MLA_NOPE_DIM + MLA_ROPE_DIM)), MLA_Q_LORA ** -0.5),
        "w_ukv": nrm(ks[8], (DEPTH, MLA_KV_LORA, MLA_HEADS * (MLA_NOPE_DIM + MLA_V_DIM)), MLA_KV_LORA ** -0.5),
        "ret_gn_g": 1.0 + nrm(ks[9], (DEPTH, RET_HEADS * RET_V_DIM), 0.02),
        "ret_gn_b": nrm(ks[10], (DEPTH, RET_HEADS * RET_V_DIM), 0.02),
        "w_out": nrm(ks[11], (DEPTH, MIX_WIDTH, D_MODEL), (MIX_WIDTH ** -0.5) * BETA),
        "ln1_g": 1.0 + nrm(ks[12], (DEPTH, D_MODEL), 0.02),
        "ln1_b": nrm(ks[13], (DEPTH, D_MODEL), 0.02),
        "w_gate": nrm(ks[14], (DEPTH, D_MODEL, D_FF), D_MODEL ** -0.5),
        "w_up": nrm(ks[15], (DEPTH, D_MODEL, D_FF), D_MODEL ** -0.5),
        "w_down": nrm(ks[16], (DEPTH, D_FF, D_MODEL), (D_FF ** -0.5) * BETA),
        "ln2_g": 1.0 + nrm(ks[17], (DEPTH, D_MODEL), 0.02),
        "ln2_b": nrm(ks[18], (DEPTH, D_MODEL), 0.02),
    }


def reference(x, positions, ln_in_g, ln_in_b, w_in, q_norm_g, kv_norm_g, w_uq, w_ukv,
              ret_gn_g, ret_gn_b, w_out, ln1_g, ln1_b, w_gate, w_up, w_down, ln2_g, ln2_b):
    cos_m, sin_m = rope_tables(positions, MLA_ROPE_DIM)
    cos_r, sin_r = rope_tables(positions, RET_QK_DIM)
    x = layer_norm(x, ln_in_g, ln_in_b)
    for l in range(DEPTH):
        h = x @ w_in[l]
        c_q, c_kv, k_rope, rq, rk, rv, rg = split_columns(h)
        a = mla_group(c_q, c_kv, k_rope, cos_m, sin_m, q_norm_g[l], kv_norm_g[l], w_uq[l], w_ukv[l])
        r = retention_group(rq, rk, rv, rg, cos_r, sin_r, ret_gn_g[l], ret_gn_b[l])
        mix = jnp.concatenate([a, r], axis=-1) @ w_out[l]
        x = layer_norm(ALPHA * x + mix, ln1_g[l], ln1_b[l])
        f = (jax.nn.silu(x @ w_gate[l]) * (x @ w_up[l])) @ w_down[l]
        x = layer_norm(ALPHA * x + f, ln2_g[l], ln2_b[l])
    return x
```

```cpp
#include <hip/hip_runtime.h>
#include <hip/hip_cooperative_groups.h>
#include <cstdio>
#include <cstdint>
namespace cg = cooperative_groups;

typedef float f32x16 __attribute__((ext_vector_type(16)));
typedef unsigned u32x2 __attribute__((ext_vector_type(2)));
typedef float f32x2_t __attribute__((ext_vector_type(2)));
typedef __bf16 bf16x2_t __attribute__((ext_vector_type(2)));
__device__ __forceinline__ unsigned pk2(float lo, float hi) { f32x2_t v = {lo, hi}; bf16x2_t b = __builtin_convertvector(v, bf16x2_t); return __builtin_bit_cast(unsigned, b); }
__device__ __forceinline__ float bf_lo(unsigned w) { return __uint_as_float(w << 16); }
__device__ __forceinline__ float bf_hi(unsigned w) { return __uint_as_float(w & 0xffff0000u); }

constexpr int TOK = 16384, SEQ = 4096, DM = 2048, DFF = 5632;
constexpr float ALPHA = 1.4142135623730951f;
constexpr float QSCALE = 0.10411754627697264f;
__device__ __forceinline__ float lg2gamma(int h) { return h == 0 ? -0.04580368961312479f : h == 1 ? -0.02272007650008353f : h == 2 ? -0.011315313227834146f : -0.005646563141142063f; }
__device__ __forceinline__ float shx(float v, int mask, int lane) { return __int_as_float(__builtin_amdgcn_ds_bpermute((lane ^ mask) << 2, __float_as_int(v))); }
namespace pg8 {
#define PG8_LAS __attribute__((address_space(3)))
typedef unsigned short bf16_t;
typedef short bf16x8 __attribute__((ext_vector_type(8)));
typedef float f32x4 __attribute__((ext_vector_type(4)));
typedef unsigned u32x4 __attribute__((ext_vector_type(4)));
constexpr int BM = 256, BK = 64, HALF = 128, HTB = HALF * BK * 2  , STAGE_BYTES = 8 * HTB, NXCD = 8, WGM = 8;

__host__ __device__ __forceinline__ int lds_byte(int r, int c) { const int st = (r >> 4) * 2 + (c >> 5), rr = r & 15, cc = c & 31, ob = rr * 64 + cc * 2; return st * 1024 + (ob ^ (((ob >> 9) & 1) << 5)); }
__host__ __device__ __forceinline__ void stage_rc(int b, int& R, int& C) { const int st = b / 1024, sb = b % 1024, swz = sb ^ (((sb >> 9) & 1) << 5); R = (st >> 1) * 16 + swz / 64; C = (st & 1) * 32 + (swz % 64) / 2; }
__host__ __device__ __forceinline__ int perm32(int rho) { const int n = rho >> 4, i = rho & 15; return 8 * (i >> 2) + 4 * n + (i & 3); }

struct Unit { int pm, pn; };
struct Gemm { const bf16_t* A; const bf16_t* Bt; int M, N, K, lda, ldb; };

struct StaticOrder {
    int nM, nN, nwg, G, c;
    __host__ __device__ void init(int M, int N, int G_, int c_) { nM = M / BM; nN = N / BM; nwg = nM * nN; G = G_; c = c_; }
    __host__ __device__ bool next(int i, Unit& u) const {
        const long L = (long)i * G + c; if (L >= nwg) return false;
        int wgid = (int)L; { const int q = nwg / NXCD, r = nwg % NXCD, xcd = wgid % NXCD, off = wgid / NXCD; wgid = (xcd < r ? xcd * (q + 1) : r * (q + 1) + (xcd - r) * q) + off; }
        const int nig = WGM * nN, gid = wgid / nig, fm = gid * WGM, gsz = (nM - fm) < WGM ? (nM - fm) : WGM;
        u.pm = fm + ((wgid % nig) % gsz); u.pn = (wgid % nig) / gsz; return true;
    }
    __device__ __forceinline__ void a_ready(const Unit&) const {}
    __device__ __forceinline__ void done(const Unit&) const {}
};
__device__ __forceinline__ unsigned cvt_pk_bf16(float lo, float hi) { return pk2(lo, hi); }
__device__ __forceinline__ u32x4 pack8(const f32x4 a, const f32x4 b) { u32x4 w; w.x = pk2(a[0], a[1]); w.y = pk2(a[2], a[3]); w.z = pk2(b[0], b[1]); w.w = pk2(b[2], b[3]); return w; }
__device__ __forceinline__ float dot4(const f32x4 a) { return (a[0] * a[0] + a[1] * a[1]) + (a[2] * a[2] + a[3] * a[3]); }

struct EpiIn {
    static constexpr bool PERM = true, AFTER_DRAIN = false;
    bf16_t* hN; bf16_t* kr; float* ssq; float* sskv; const float* cosT; const float* sinT;
    __device__ __forceinline__ void operator()(const f32x4 (&acc)[2][2][4][2], const Unit& u, int wr, int wc, int fr, int fq) const {
        { int t_ = threadIdx.x; asm volatile("" : "+v"(t_)); fr = t_ & 15; fq = (t_ >> 4) & 3; }
        const int pn = u.pn, row0 = u.pm * BM + wr * 64 + fr, cl = wc * 32 + 8 * fq;
        if (pn >= 8) {
            const float sc = pn < 12 ? 0.0625f : 1.0f;
#pragma unroll
            for (int ai = 0; ai < 2; ++ai)
#pragma unroll
                for (int m = 0; m < 4; ++m) {
                    const int row = row0 + ai * HALF + m * 16;
                    const float* cp = cosT + (size_t)row * 128 + cl; const float* sp = sinT + (size_t)row * 128 + cl;
                    const f32x4 c0 = *(const f32x4*)cp, c1 = *(const f32x4*)(cp + 4), s0 = *(const f32x4*)sp, s1 = *(const f32x4*)(sp + 4);
                    const f32x4 a0 = acc[ai][0][m][0], a1 = acc[ai][0][m][1], b0 = acc[ai][1][m][0], b1 = acc[ai][1][m][1];
                    const f32x4 o10 = (a0 * c0 - b0 * s0) * sc, o11 = (a1 * c1 - b1 * s1) * sc, o20 = (b0 * c0 + a0 * s0) * sc, o21 = (b1 * c1 + a1 * s1) * sc;
                    bf16_t* p = hN + (size_t)row * 4096 + pn * 256 + cl;
                    *(u32x4*)p = pack8(o10, o11); *(u32x4*)(p + 128) = pack8(o20, o21); asm volatile("" ::: "memory");
                }
        } else if (pn == 3) {
            if (wc == 0) {
#pragma unroll
                for (int ai = 0; ai < 2; ++ai)
#pragma unroll
                    for (int m = 0; m < 4; ++m) {
                        const int row = row0 + ai * HALF + m * 16;
                        const float* cp = cosT + (size_t)row * 128 + 32 * fq; const float* sp = sinT + (size_t)row * 128 + 32 * fq;
                        f32x4 c0, c1, s0, s1;
#pragma unroll
                        for (int j = 0; j < 4; ++j) { c0[j] = cp[4 * j]; c1[j] = cp[16 + 4 * j]; s0[j] = sp[4 * j]; s1[j] = sp[16 + 4 * j]; }
                        const f32x4 a0 = acc[ai][0][m][0], a1 = acc[ai][0][m][1], b0 = acc[ai][1][m][0], b1 = acc[ai][1][m][1];
                        const f32x4 o10 = a0 * c0 - b0 * s0, o11 = a1 * c1 - b1 * s1, o20 = b0 * c0 + a0 * s0, o21 = b1 * c1 + a1 * s1;
                        bf16_t* p = kr + (size_t)row * 64 + 8 * fq;
                        *(u32x4*)p = pack8(o10, o11); *(u32x4*)(p + 32) = pack8(o20, o21); asm volatile("" ::: "memory");
                    }
            }
        } else {
            float* ss = pn < 2 ? ssq : sskv;
#pragma unroll
            for (int ai = 0; ai < 2; ++ai)
#pragma unroll
                for (int m = 0; m < 4; ++m) {
                    const int row = row0 + ai * HALF + m * 16; float s = 0.f;
#pragma unroll
                    for (int bj = 0; bj < 2; ++bj) {
                        const f32x4 v0 = acc[ai][bj][m][0], v1 = acc[ai][bj][m][1];
                        *(u32x4*)(hN + (size_t)row * 4096 + pn * 256 + bj * HALF + cl) = pack8(v0, v1);
                        s += dot4(v0) + dot4(v1);
                    }
                    if (pn < 3) { s += shx(s, 16, fq * 16 + fr); s += shx(s, 32, fq * 16 + fr); if (fq == 0) atomicAdd(ss + row, s); }
                }
        }
    }
};
struct EpiInT {
    static constexpr bool PERM = true, AFTER_DRAIN = false;
    bf16_t* hT; const float* cosT; const float* sinT;
    __device__ __forceinline__ void operator()(const f32x4 (&acc)[2][2][4][2], const Unit& u, int wr, int wc, int fr, int fq) const {
        { int t_ = threadIdx.x; asm volatile("" : "+v"(t_)); fr = t_ & 15; fq = (t_ >> 4) & 3; }
        const int pm = u.pm, tok0 = u.pn * BM + wc * 32 + 8 * fq;
        if (pm < 4) {
            const float lg2 = lg2gamma(pm);
#pragma unroll
            for (int m = 0; m < 4; ++m) {
                const int i = wr * 64 + m * 16 + fr;
#pragma unroll
                for (int bj = 0; bj < 2; ++bj) {
                    const int tok = tok0 + bj * HALF;
                    f32x4 o1[2], o2[2];
#pragma unroll
                    for (int n = 0; n < 2; ++n)
#pragma unroll
                        for (int j = 0; j < 4; ++j) {
                            const int t = tok + 4 * n + j;
                            const float c = cosT[(size_t)t * 128 + i], s = sinT[(size_t)t * 128 + i];
                            const float dec = __builtin_amdgcn_exp2f(lg2 * (float)(63 - (t & 63)));
                            const float t1 = acc[0][bj][m][n][j], t2 = acc[1][bj][m][n][j];
                            o1[n][j] = (t1 * c - t2 * s) * dec; o2[n][j] = (t2 * c + t1 * s) * dec;
                        }
                    *(u32x4*)(hT + (size_t)(pm * 256 + i) * TOK + tok) = pack8(o1[0], o1[1]);
                    *(u32x4*)(hT + (size_t)(pm * 256 + 128 + i) * TOK + tok) = pack8(o2[0], o2[1]); asm volatile("" ::: "memory");
                }
            }
        } else {
#pragma unroll
            for (int ai = 0; ai < 2; ++ai)
#pragma unroll
                for (int m = 0; m < 4; ++m) {
                    const int r = pm * 256 + ai * HALF + wr * 64 + m * 16 + fr;
#pragma unroll
                    for (int bj = 0; bj < 2; ++bj) *(u32x4*)(hT + (size_t)r * TOK + tok0 + bj * HALF) = pack8(acc[ai][bj][m][0], acc[ai][bj][m][1]);
                }
        }
    }
};
struct EpiQ {
    static constexpr bool PERM = true, AFTER_DRAIN = false;
    bf16_t* Q; const float* ssq; const float* cosT; const float* sinT;
    __device__ __forceinline__ void operator()(const f32x4 (&acc)[2][2][4][2], const Unit& u, int wr, int wc, int fr, int fq) const {
        { int t_ = threadIdx.x; asm volatile("" : "+v"(t_)); fr = t_ & 15; fq = (t_ >> 4) & 3; }
        const int pn = u.pn, row0 = u.pm * BM + wr * 64 + fr;
#pragma unroll
        for (int ai = 0; ai < 2; ++ai)
#pragma unroll
            for (int m = 0; m < 4; ++m) {
                const int row = row0 + ai * HALF + m * 16;
                const float rs = rsqrtf(ssq[row] * (1.0f / 512.0f) + 1e-6f) * QSCALE;
                if (pn < 4) {
#pragma unroll
                    for (int bj = 0; bj < 2; ++bj)
                        *(u32x4*)(Q + (size_t)row * 1536 + (2 * pn + bj) * 192 + wc * 32 + 8 * fq) = pack8(acc[ai][bj][m][0] * rs, acc[ai][bj][m][1] * rs);
                } else {
                    const float* cp = cosT + (size_t)row * 128 + 32 * fq; const float* sp = sinT + (size_t)row * 128 + 32 * fq;
                    f32x4 c0, c1, s0, s1;
#pragma unroll
                    for (int j = 0; j < 4; ++j) { c0[j] = cp[4 * j]; c1[j] = cp[16 + 4 * j]; s0[j] = sp[4 * j]; s1[j] = sp[16 + 4 * j]; }
                    const f32x4 a0 = acc[ai][0][m][0] * rs, a1 = acc[ai][0][m][1] * rs, b0 = acc[ai][1][m][0] * rs, b1 = acc[ai][1][m][1] * rs;
                    const f32x4 o10 = a0 * c0 - b0 * s0, o11 = a1 * c1 - b1 * s1, o20 = b0 * c0 + a0 * s0, o21 = b1 * c1 + a1 * s1;
                    bf16_t* p = Q + (size_t)row * 1536 + (4 * (pn - 4) + wc) * 192 + 128 + 8 * fq;
                    *(u32x4*)p = pack8(o10, o11); *(u32x4*)(p + 32) = pack8(o20, o21); asm volatile("" ::: "memory");
                }
            }
    }
};
struct EpiK {
    static constexpr bool PERM = true, AFTER_DRAIN = false;
    bf16_t* Kn; const float* sskv;
    __device__ __forceinline__ void operator()(const f32x4 (&acc)[2][2][4][2], const Unit& u, int wr, int wc, int fr, int fq) const {
        { int t_ = threadIdx.x; asm volatile("" : "+v"(t_)); fr = t_ & 15; fq = (t_ >> 4) & 3; }
        const int row0 = u.pm * BM + wr * 64 + fr, col0 = u.pn * BM + wc * 32 + 8 * fq;
#pragma unroll
        for (int ai = 0; ai < 2; ++ai)
#pragma unroll
            for (int m = 0; m < 4; ++m) {
                const int row = row0 + ai * HALF + m * 16;
                const float rs = rsqrtf(sskv[row] * (1.0f / 256.0f) + 1e-6f);
#pragma unroll
                for (int bj = 0; bj < 2; ++bj) *(u32x4*)(Kn + (size_t)row * 1024 + col0 + bj * HALF) = pack8(acc[ai][bj][m][0] * rs, acc[ai][bj][m][1] * rs);
            }
    }
};
struct EpiVT {
    static constexpr bool PERM = true, AFTER_DRAIN = false;
    bf16_t* VT; const float* sskv;
    __device__ __forceinline__ void operator()(const f32x4 (&acc)[2][2][4][2], const Unit& u, int wr, int wc, int fr, int fq) const {
        { int t_ = threadIdx.x; asm volatile("" : "+v"(t_)); fr = t_ & 15; fq = (t_ >> 4) & 3; }
        const int tok0 = u.pn * BM + wc * 32 + 8 * fq;
        f32x4 rs[2][2];
#pragma unroll
        for (int bj = 0; bj < 2; ++bj)
#pragma unroll
            for (int n = 0; n < 2; ++n) { const f32x4 s = *(const f32x4*)(sskv + tok0 + bj * HALF + 4 * n);
#pragma unroll
                for (int j = 0; j < 4; ++j) rs[bj][n][j] = rsqrtf(s[j] * (1.0f / 256.0f) + 1e-6f); }
#pragma unroll
        for (int ai = 0; ai < 2; ++ai)
#pragma unroll
            for (int m = 0; m < 4; ++m) {
                const int r = u.pm * BM + ai * HALF + wr * 64 + m * 16 + fr;
#pragma unroll
                for (int bj = 0; bj < 2; ++bj) *(u32x4*)(VT + (size_t)r * TOK + tok0 + bj * HALF) = pack8(acc[ai][bj][m][0] * rs[bj][0], acc[ai][bj][m][1] * rs[bj][1]);
            }
    }
};
struct EpiRes {
    static constexpr bool PERM = true, AFTER_DRAIN = false;
    float* x;
    __device__ __forceinline__ void operator()(const f32x4 (&acc)[2][2][4][2], const Unit& u, int wr, int wc, int fr, int fq) const {
        { int t_ = threadIdx.x; asm volatile("" : "+v"(t_)); fr = t_ & 15; fq = (t_ >> 4) & 3; }
        const int row0 = u.pm * BM + wr * 64 + fr, col0 = u.pn * BM + wc * 32 + 8 * fq;
#pragma unroll
        for (int ai = 0; ai < 2; ++ai)
#pragma unroll
            for (int m = 0; m < 4; ++m) {
                float* rp = x + (size_t)(row0 + ai * HALF + m * 16) * DM + col0;
#pragma unroll
                for (int bj = 0; bj < 2; ++bj)
#pragma unroll
                    for (int n = 0; n < 2; ++n) { f32x4* p = (f32x4*)(rp + bj * HALF + 4 * n); *p = *p * ALPHA + acc[ai][bj][m][n]; }
                asm volatile("" ::: "memory");
            }
    }
};
struct EpiGU {
    static constexpr bool PERM = true, AFTER_DRAIN = false;
    bf16_t* act;
    __device__ __forceinline__ void operator()(const f32x4 (&acc)[2][2][4][2], const Unit& u, int wr, int wc, int fr, int fq) const {
        { int t_ = threadIdx.x; asm volatile("" : "+v"(t_)); fr = t_ & 15; fq = (t_ >> 4) & 3; }
        const int row0 = u.pm * BM + wr * 64 + fr, col0 = u.pn * 128 + wc * 16 + 4 * fq;
#pragma unroll
        for (int ai = 0; ai < 2; ++ai)
#pragma unroll
            for (int m = 0; m < 4; ++m) {
                bf16_t* rp = act + (size_t)(row0 + ai * HALF + m * 16) * DFF + col0;
#pragma unroll
                for (int bj = 0; bj < 2; ++bj) {
                    const f32x4 g = acc[ai][bj][m][0], up = acc[ai][bj][m][1]; f32x4 o;
#pragma unroll
                    for (int j = 0; j < 4; ++j) o[j] = g[j] * __builtin_amdgcn_rcpf(1.0f + __builtin_amdgcn_exp2f(-1.4426950408889634f * g[j])) * up[j];
                    u32x2 w; w.x = pk2(o[0], o[1]); w.y = pk2(o[2], o[3]);
                    *(u32x2*)(rp + bj * 64) = w;
                }
            }
    }
};

template <class Epi, class Sched, bool ALIGN_EPI = false, bool SP2 = false>
__device__ __forceinline__ void gemm_phase(PG8_LAS unsigned char* lds, const Gemm g, const Sched& S, const Epi& E) {
    int tid_ = threadIdx.x; asm volatile("" : "+v"(tid_));
    const int tid = tid_, wid = __builtin_amdgcn_readfirstlane(tid >> 6), lane = tid & 63, wr = wid >> 2, wc = wid & 3, fr = lane & 15, fq = lane >> 4;
    const int K = g.K, nt = K / BK;
    unsigned voffA[2], voffB[2];
#pragma unroll
    for (int i = 0; i < 2; ++i) { int R, C; stage_rc(tid * 16 + i * 8192, R, C); const int Rb = Epi::PERM ? ((R & ~31) + perm32(R & 31)) : R;
        voffA[i] = (unsigned)(R * g.lda + C) * 2u; voffB[i] = (unsigned)(Rb * g.ldb + C) * 2u; }
    const size_t kstep = (size_t)(BK * 2);
    const size_t hstepA = (size_t)HALF * g.lda * 2, hstepB = (size_t)HALF * g.ldb * 2;
    const size_t tstepA = 2 * hstepA, tstepB = 2 * hstepB;
    const unsigned ldsw = (unsigned)wid * 1024u;
    const int aoff = lds_byte(wr * 64 + fr, fq * 8), boff = lds_byte(wc * 32 + fr, fq * 8);
#define PG8_SA(b, h) (((b) * 2 + (h)) * HTB)
#define PG8_SB(b, h) ((4 + (b) * 2 + (h)) * HTB)
#define PG8_STAGE(bufoff, gbase, voff) do { _Pragma("unroll") for (int _i = 0; _i < 2; ++_i) \
        __builtin_amdgcn_global_load_lds((const unsigned*)((const char*)(gbase) + (voff)[_i]), (PG8_LAS unsigned*)(lds + (bufoff) + ldsw + _i * 8192), 16, 0, 0); } while (0)
#define PG8_LDA(dst, b, h) do { _Pragma("unroll") for (int m = 0; m < 4; ++m) _Pragma("unroll") for (int k = 0; k < 2; ++k) dst[m][k] = *(const PG8_LAS bf16x8*)(lds + PG8_SA(b, h) + aoff + m * 2048 + k * 1024); } while (0)
#define PG8_LDB(dst, b, h) do { _Pragma("unroll") for (int n = 0; n < 2; ++n) _Pragma("unroll") for (int k = 0; k < 2; ++k) dst[n][k] = *(const PG8_LAS bf16x8*)(lds + PG8_SB(b, h) + boff + n * 2048 + k * 1024); } while (0)
#define PG8_MMA(ai, bj, At, Bt) do { __builtin_amdgcn_s_setprio(1); _Pragma("unroll") for (int m = 0; m < 4; ++m) _Pragma("unroll") for (int n = 0; n < 2; ++n) _Pragma("unroll") for (int k = 0; k < 2; ++k) \
        acc[ai][bj][m][n] = __builtin_amdgcn_mfma_f32_16x16x32_bf16(Bt[n][k], At[m][k], acc[ai][bj][m][n], 0, 0, 0); __builtin_amdgcn_s_setprio(0); } while (0)
#define PG8_WAIT_V(n) asm volatile("s_waitcnt vmcnt(" #n ")" ::: "memory")
#define PG8_WAIT_L(n) asm volatile("s_waitcnt lgkmcnt(" #n ")" ::: "memory")
#define PG8_BAR __builtin_amdgcn_s_barrier()
#define PG8_SCHED __builtin_amdgcn_sched_barrier(0)
    Unit cur, nxt; int ui = 0;
    if (!S.next(0, cur)) return;
    f32x4 acc[2][2][4][2];
#pragma unroll
    for (int a = 0; a < 2; ++a)
#pragma unroll
        for (int b = 0; b < 2; ++b)
#pragma unroll
            for (int m = 0; m < 4; ++m)
#pragma unroll
                for (int n = 0; n < 2; ++n) acc[a][b][m][n] = (f32x4){0.f, 0.f, 0.f, 0.f};
    bf16x8 At[4][2], B0[2][2], B1[2][2];
    const char* cA = (const char*)g.A + (size_t)cur.pm * tstepA; const char* cB = (const char*)g.Bt + (size_t)cur.pn * tstepB;
    S.a_ready(cur);
    if constexpr (SP2) {
        PG8_STAGE(PG8_SB(0, 0), cB, voffB); PG8_STAGE(PG8_SB(0, 1), cB + hstepB, voffB); PG8_STAGE(PG8_SA(0, 0), cA, voffA); PG8_STAGE(PG8_SA(0, 1), cA + hstepA, voffA);
        if (wr == 1) PG8_BAR;
        PG8_WAIT_V(2); PG8_BAR;
        PG8_STAGE(PG8_SB(1, 0), cB + kstep, voffB); PG8_STAGE(PG8_SA(1, 0), cA + kstep, voffA); PG8_STAGE(PG8_SB(1, 1), cB + hstepB + kstep, voffB);
        PG8_WAIT_V(6); PG8_BAR;
    } else {
        PG8_STAGE(PG8_SB(0, 0), cB, voffB); PG8_STAGE(PG8_SA(0, 0), cA, voffA); PG8_STAGE(PG8_SB(0, 1), cB + hstepB, voffB); PG8_STAGE(PG8_SA(0, 1), cA + hstepA, voffA);
        if (wr == 1) PG8_BAR;
        PG8_WAIT_V(4); PG8_BAR;
        PG8_STAGE(PG8_SB(1, 0), cB + kstep, voffB); PG8_STAGE(PG8_SA(1, 0), cA + kstep, voffA); PG8_STAGE(PG8_SB(1, 1), cB + hstepB + kstep, voffB);
        PG8_WAIT_V(6); PG8_BAR;
    }
    for (;;) {
        const bool has_next = S.next(ui + 1, nxt);
        const char* nA = has_next ? (const char*)g.A + (size_t)nxt.pm * tstepA : cA; const char* nB = has_next ? (const char*)g.Bt + (size_t)nxt.pn * tstepB : cB;
        for (int t = 0; t < nt; t += 2) {
            const bool last = (t == nt - 2);
            const char* a1 = cA + (size_t)(t + 1) * kstep;
            const char* a2 = last ? nA : cA + (size_t)(t + 2) * kstep; const char* b2 = last ? nB : cB + (size_t)(t + 2) * kstep;
            const char* a3 = a2 + kstep; const char* b3 = b2 + kstep;
            if (last && has_next) S.a_ready(nxt);
            if constexpr (SP2) {
            PG8_LDB(B0, 0, 0); PG8_LDB(B1, 0, 1); PG8_SCHED; PG8_LDA(At, 0, 0); PG8_STAGE(PG8_SA(1, 1), a1 + hstepA, voffA);
            PG8_WAIT_V(8); PG8_WAIT_L(0); PG8_BAR; PG8_MMA(0, 0, At, B0); PG8_MMA(0, 1, At, B1); PG8_BAR; PG8_SCHED;
            PG8_LDA(At, 0, 1); PG8_STAGE(PG8_SB(0, 0), b2, voffB); PG8_STAGE(PG8_SB(0, 1), b2 + hstepB, voffB); PG8_STAGE(PG8_SA(0, 0), a2, voffA);
            PG8_WAIT_V(8); PG8_WAIT_L(0); PG8_BAR; PG8_MMA(1, 0, At, B0); PG8_MMA(1, 1, At, B1); PG8_BAR; PG8_SCHED;
            PG8_LDB(B0, 1, 0); PG8_LDB(B1, 1, 1); PG8_SCHED; PG8_LDA(At, 1, 0); PG8_STAGE(PG8_SA(0, 1), a2 + hstepA, voffA);
            PG8_WAIT_V(8); PG8_WAIT_L(0); PG8_BAR; PG8_MMA(0, 0, At, B0); PG8_MMA(0, 1, At, B1); PG8_BAR; PG8_SCHED;
            PG8_LDA(At, 1, 1); PG8_STAGE(PG8_SB(1, 0), b3, voffB); PG8_STAGE(PG8_SB(1, 1), b3 + hstepB, voffB); PG8_STAGE(PG8_SA(1, 0), a3, voffA);
            PG8_WAIT_V(8); PG8_WAIT_L(0); PG8_BAR; PG8_MMA(1, 0, At, B0); PG8_MMA(1, 1, At, B1); PG8_BAR; PG8_SCHED;
            } else {
            PG8_LDB(B0, 0, 0); PG8_SCHED; PG8_LDA(At, 0, 0); PG8_STAGE(PG8_SA(1, 1), a1 + hstepA, voffA);
            PG8_WAIT_L(8); PG8_BAR; PG8_WAIT_L(0); PG8_MMA(0, 0, At, B0); PG8_BAR; PG8_SCHED;
            PG8_LDB(B1, 0, 1); PG8_STAGE(PG8_SB(0, 0), b2, voffB);
            PG8_BAR; PG8_WAIT_L(0); PG8_MMA(0, 1, At, B1); PG8_BAR;
            PG8_LDA(At, 0, 1); PG8_STAGE(PG8_SA(0, 0), a2, voffA);
            PG8_BAR; PG8_WAIT_L(0); PG8_MMA(1, 0, At, B0); PG8_BAR; PG8_SCHED;
            PG8_STAGE(PG8_SB(0, 1), b2 + hstepB, voffB);
            PG8_WAIT_V(6); PG8_BAR; PG8_MMA(1, 1, At, B1); PG8_BAR;
            PG8_LDB(B0, 1, 0); PG8_SCHED; PG8_LDA(At, 1, 0); PG8_STAGE(PG8_SA(0, 1), a2 + hstepA, voffA);
            PG8_WAIT_L(8); PG8_BAR; PG8_WAIT_L(0); PG8_MMA(0, 0, At, B0); PG8_BAR; PG8_SCHED;
            PG8_LDB(B1, 1, 1); PG8_STAGE(PG8_SB(1, 0), b3, voffB);
            PG8_BAR; PG8_WAIT_L(0); PG8_MMA(0, 1, At, B1); PG8_BAR;
            PG8_LDA(At, 1, 1); PG8_STAGE(PG8_SA(1, 0), a3, voffA);
            PG8_BAR; PG8_WAIT_L(0); PG8_MMA(1, 0, At, B0); PG8_BAR; PG8_SCHED;
            PG8_STAGE(PG8_SB(1, 1), b3 + hstepB, voffB);
            PG8_WAIT_V(6); PG8_BAR; PG8_MMA(1, 1, At, B1); PG8_BAR;
            }
        }
        if constexpr (ALIGN_EPI) { if (wr == 0) PG8_BAR; }
        if constexpr (!Epi::AFTER_DRAIN) { E(acc, cur, wr, wc, fr, fq); S.done(cur); }
        if (!has_next) break;
#pragma unroll
        for (int a = 0; a < 2; ++a)
#pragma unroll
            for (int b = 0; b < 2; ++b)
#pragma unroll
                for (int m = 0; m < 4; ++m)
#pragma unroll
                    for (int n = 0; n < 2; ++n) acc[a][b][m][n] = (f32x4){0.f, 0.f, 0.f, 0.f};
        cur = nxt; cA = nA; cB = nB; ++ui;
        if constexpr (ALIGN_EPI) { if (wr == 1) PG8_BAR; }
    }
    PG8_WAIT_V(0);
    if constexpr (!ALIGN_EPI) { if (wr == 0) PG8_BAR; }
    PG8_BAR;
    if constexpr (Epi::AFTER_DRAIN) { E.fused(acc, cur, wr, wc, fr, fq, lds, wid, lane); S.done(cur); }
#undef PG8_SA
#undef PG8_SB
#undef PG8_STAGE
#undef PG8_LDA
#undef PG8_LDB
#undef PG8_MMA
#undef PG8_WAIT_V
#undef PG8_WAIT_L
#undef PG8_BAR
#undef PG8_SCHED
}
}
#define PG8_SP2 true
#define PG8_ALIGN true

#define LAS __attribute__((address_space(3)))
using pg8::bf16_t; using pg8::bf16x8; using pg8::f32x4; using pg8::u32x4;
#define MFMA32(a, b, c) __builtin_amdgcn_mfma_f32_32x32x16_bf16((a), (b), (c), 0, 0, 0)
constexpr size_t MiB = 1u << 20;
constexpr size_t WS_SS = 0;
constexpr size_t WS_BAR = 512 * 1024;
constexpr size_t WS_WIN = 1 * MiB;
constexpr size_t WS_WUQ = 25 * MiB;
constexpr size_t WS_WKV = 26 * MiB + 512 * 1024;
constexpr size_t WS_WOUT = 28 * MiB;
constexpr size_t WS_TAB = 36 * MiB;
constexpr size_t WS_HN = 52 * MiB;
constexpr size_t WS_HT = 180 * MiB;
constexpr size_t WS_XB = 244 * MiB;
constexpr size_t WS_Q = 244 * MiB, WS_KR = 500 * MiB;
constexpr size_t WS_ST = 308 * MiB;
constexpr size_t WS_WGU = 308 * MiB, WS_WD = 352 * MiB;
constexpr size_t WS_KN = 436 * MiB;
constexpr size_t WS_VT = 468 * MiB;
constexpr size_t WS_ACT = 52 * MiB;
constexpr size_t WS_END = 502 * MiB;
constexpr int LDS_BYTES = 131072 + 1024;
constexpr int NPH = 17;

__device__ __forceinline__ float wave_sum(float v, int lane) {
#pragma unroll
    for (int o = 1; o < 64; o <<= 1) v += shx(v, o, lane);
    return v;
}
#define XB_TMO      128
#define XB_XCNT(j)  (256  + 64 * (j))
#define XB_XSUB(j)  (1280 + 64 * (j))
#define XB_XGEN(j)  (2304 + 64 * (j))
#define XB_TOP      3328
#define XB_TOPGEN   3392
#define XCD_BAR_WORDS 3456
#define XB_SPIN_CAP (1u << 18)

__device__ __forceinline__ unsigned xb_ld(unsigned* p)              { return __hip_atomic_load(p, __ATOMIC_RELAXED, __HIP_MEMORY_SCOPE_AGENT); }
__device__ __forceinline__ unsigned xb_add(unsigned* p, unsigned v) { return __hip_atomic_fetch_add(p, v, __ATOMIC_RELAXED, __HIP_MEMORY_SCOPE_AGENT); }
__device__ __forceinline__ unsigned xb_xcc_id() { return (unsigned)__builtin_amdgcn_s_getreg((3 << 11) | 20) & 0xFu; }
#define XB_SPIN(cond, bar) do { unsigned _sp = 0; while (cond) { __builtin_amdgcn_s_sleep(1); \
    if ((++_sp & 255u) == 0u) { if (xb_ld(&(bar)[XB_TMO])) break; if (_sp > XB_SPIN_CAP) { atomicAdd(&(bar)[XB_TMO], 1u); break; } } } } while (0)

struct XcdBarrier {
    unsigned* bar; unsigned x;
    volatile LAS unsigned* st;
};

__device__ __forceinline__ XcdBarrier xcd_barrier_post(unsigned* bar, volatile LAS unsigned* st) {
    XcdBarrier b; b.bar = bar; b.x = xb_xcc_id(); b.st = st;
    if (threadIdx.x == 0) (void)xb_add(&bar[XB_XCNT(b.x)], 1u);
    return b;
}
__device__ __forceinline__ void xcd_barrier_complete(unsigned* bar, unsigned x, unsigned& nloc, unsigned& nx) {
    const unsigned G = gridDim.x * gridDim.y * gridDim.z;
    unsigned sum, cnt, mine, sp = 0u;
    for (;;) {
        sum = 0u; cnt = 0u; mine = 0u;
#pragma unroll
        for (unsigned j = 0; j < 16; ++j) { const unsigned c = xb_ld(&bar[XB_XCNT(j)]); sum += c; cnt += (c > 0u) ? 1u : 0u; mine = (j == x) ? c : mine; }
        if (sum == G) break;
        __builtin_amdgcn_s_sleep(1);
        if ((++sp & 255u) == 0u) { if (xb_ld(&bar[XB_TMO])) break; if (sp > XB_SPIN_CAP) { atomicAdd(&bar[XB_TMO], 1u); break; } }
    }
    nloc = mine > 0u ? mine : 1u; nx = cnt > 0u ? cnt : 1u;
}

__device__ __forceinline__ void xcd_barrier(const XcdBarrier& b) {
    asm volatile("s_waitcnt vmcnt(0)" ::: "memory");
    __syncthreads();
    if (threadIdx.x == 0) {
        unsigned* bar = b.bar;
        __builtin_amdgcn_s_waitcnt(0);
        unsigned nloc = b.st[0], nx = b.st[1];
        if (nloc == 0u) { xcd_barrier_complete(bar, b.x, nloc, nx); b.st[0] = nloc; b.st[1] = nx; }
        const unsigned old = xb_add(&bar[XB_XSUB(b.x)], 1u);
        const unsigned gen = old / nloc;
        if (old + 1u == (gen + 1u) * nloc) {
            __builtin_amdgcn_fence(__ATOMIC_RELEASE, "agent");
            asm volatile("s_waitcnt vmcnt(0)" ::: "memory");
            const unsigned og = xb_add(&bar[XB_TOP], 1u);
            const unsigned tg = og / nx;
            if (og + 1u == (tg + 1u) * nx) xb_add(&bar[XB_TOPGEN], 1u);
            else XB_SPIN(xb_ld(&bar[XB_TOPGEN]) == tg, bar);
            __builtin_amdgcn_fence(__ATOMIC_ACQUIRE, "agent");
            xb_add(&bar[XB_XGEN(b.x)], 1u);
            asm volatile("s_waitcnt vmcnt(0)" ::: "memory");
        } else {
            XB_SPIN(xb_ld(&bar[XB_XGEN(b.x)]) == gen, bar);
            __builtin_amdgcn_fence(__ATOMIC_ACQUIRE, "agent");
            asm volatile("s_waitcnt vmcnt(0)" ::: "memory");
        }
    }
    __syncthreads();
}

template <int MODE> __device__ __forceinline__ void rowmap(int n, int& r1, int& r2) {
    r2 = -1;
    if (MODE == 0) {
        if (n < 800) r1 = n;
        else if (n < 832) r1 = n + 96;
        else if (n < 1856) r1 = 2048 + (n - 832);
        else if (n < 2880) { r1 = 3072 + (n - 1856); r2 = 4096 + (n - 1856); }
        else if (n < 3904) r1 = 5120 + (n - 2880);
        else r1 = 1024 + (n - 3904);
    } else if (MODE == 1) {
        const int h = n / 192, d = n % 192;
        if (d < 128) r1 = (h >> 1) * 256 + (h & 1) * 128 + d;
        else { const int i = d - 128; r1 = 1024 + (h >> 2) * 256 + (i >> 5) * 128 + (h & 3) * 32 + (i & 31); }
    } else if (MODE == 2) {
        const int h = n >> 8, d = n & 255;
        r1 = d < 128 ? h * 128 + d : 1024 + h * 128 + (d - 128);
    } else if (MODE == 3) r1 = n;
    else if (MODE == 4) r1 = 8 * (n >> 2) + (n & 3);
    else r1 = 8 * (n >> 2) + 4 + (n & 3);
}
template <int MODE> __device__ __forceinline__ void cvt_item(const float* __restrict__ W, int K, int N, const float* __restrict__ ksc, bf16_t* WT, LAS float* scr, int item, int lane) {
    const int nblk = N / 32, kb = item / nblk, nb = item % nblk, k0 = 64 * kb, n0 = 32 * nb;
#pragma unroll 8
    for (int i = 0; i < 32; ++i) { const int kk = 2 * i + (lane >> 5); float v = W[(size_t)(k0 + kk) * N + n0 + (lane & 31)]; if (ksc) v *= ksc[k0 + kk]; scr[kk * 33 + (lane & 31)] = v; }
    asm volatile("s_waitcnt lgkmcnt(0)" ::: "memory");
    const int c = lane & 7;
#pragma unroll
    for (int j = 0; j < 4; ++j) {
        const int n = (lane >> 3) + 8 * j; const LAS float* s = scr + (8 * c) * 33 + n;
        u32x4 o; o.x = pk2(s[0 * 33], s[1 * 33]); o.y = pk2(s[2 * 33], s[3 * 33]); o.z = pk2(s[4 * 33], s[5 * 33]); o.w = pk2(s[6 * 33], s[7 * 33]);
        int r1, r2; rowmap<MODE>(n0 + n, r1, r2);
        *(u32x4*)(WT + (size_t)r1 * K + k0 + 8 * c) = o;
        if (MODE == 0) { if (r2 >= 0) *(u32x4*)(WT + (size_t)r2 * K + k0 + 8 * c) = o; }
    }
    asm volatile("s_waitcnt lgkmcnt(0)" ::: "memory");
}
__device__ __forceinline__ void ln_row(const float* src, float* dstf, bf16_t* dstb, const float* __restrict__ g, const float* __restrict__ b, int lane) {
    f32x4 v[8]; float s = 0.f;
#pragma unroll
    for (int j = 0; j < 8; ++j) { v[j] = ((const f32x4*)src)[lane + 64 * j]; s += (v[j][0] + v[j][1]) + (v[j][2] + v[j][3]); }
    const float mean = wave_sum(s, lane) * (1.0f / 2048.0f); float s2 = 0.f;
#pragma unroll
    for (int j = 0; j < 8; ++j) { v[j] = v[j] - mean; s2 += pg8::dot4(v[j]); }
    const float rstd = rsqrtf(wave_sum(s2, lane) * (1.0f / 2048.0f) + 1e-5f);
#pragma unroll
    for (int j = 0; j < 8; ++j) {
        const f32x4 gg = ((const f32x4*)g)[lane + 64 * j], bb = ((const f32x4*)b)[lane + 64 * j];
        const f32x4 o = v[j] * rstd * gg + bb;
        ((f32x4*)dstf)[lane + 64 * j] = o;
        u32x2 w; w.x = pk2(o[0], o[1]); w.y = pk2(o[2], o[3]);
        ((u32x2*)dstb)[lane + 64 * j] = w;
    }
}
__device__ __forceinline__ int sig32(int r) { return (r & 0x13) | ((r & 4) << 1) | ((r & 8) >> 1); }
__device__ __forceinline__ bf16x8 pack_half(const f32x16& x, int s) {
    u32x4 p; p.x = pk2(x[8 * s + 0], x[8 * s + 1]); p.y = pk2(x[8 * s + 2], x[8 * s + 3]); p.z = pk2(x[8 * s + 4], x[8 * s + 5]); p.w = pk2(x[8 * s + 6], x[8 * s + 7]);
    return __builtin_bit_cast(bf16x8, p);
}
__device__ __forceinline__ f32x16 zero16() { f32x16 z;
#pragma unroll
    for (int i = 0; i < 16; ++i) z[i] = 0.f; return z; }

__device__ __forceinline__ bf16x8 ldf(const bf16_t* ub, unsigned off) { return *(const bf16x8*)((const char*)ub + off); }
__device__ __forceinline__ u32x2 ld8(const bf16_t* ub, unsigned off) { return *(const u32x2*)((const char*)ub + off); }
__device__ __forceinline__ void st8(bf16_t* ub, unsigned off, u32x2 v) { *(u32x2*)((char*)ub + off) = v; }

__device__ __forceinline__ void scan_wave(const bf16_t* __restrict__ hT, bf16_t* __restrict__ ST, int wt, int lane) {
    asm volatile("" : "+v"(lane));
    const int r32 = lane & 31, hi = lane >> 5;
    const int bh = wt >> 6, it = (wt >> 3) & 7, jt = wt & 7, h = bh & 3, b = bh >> 2;
    const bf16_t* kd = hT + (size_t)(h * 256 + 32 * it) * TOK + (size_t)b * SEQ;
    const bf16_t* vv = hT + (size_t)(1024 + h * 256 + 32 * jt) * TOK + (size_t)b * SEQ;
    const unsigned lo = (unsigned)(r32 * TOK + 8 * hi) * 2u;
    bf16_t* so = ST + ((size_t)(bh * 64) << 16) + (32 * jt) * 256 + 32 * it;
    const unsigned so_l = (unsigned)(r32 * 256 + 4 * hi) * 2u;
    const float g64 = __builtin_amdgcn_exp2f(64.0f * lg2gamma(h));
    f32x16 st = zero16();
#pragma unroll 2
    for (int c = 0; c < 64; ++c) {
#pragma unroll
        for (int a = 0; a < 4; ++a) { u32x2 w; w.x = pk2(st[4 * a], st[4 * a + 1]); w.y = pk2(st[4 * a + 2], st[4 * a + 3]); st8(so + ((size_t)c << 16) + 8 * a, so_l, w); }
        if (c < 63) {
            st = st * g64;
#pragma unroll
            for (int ks = 0; ks < 4; ++ks) {
                const bf16x8 af = ldf(kd + 64 * c + 16 * ks, lo), bfr = ldf(vv + 64 * c + 16 * ks, lo);
                st = MFMA32(af, bfr, st);
            }
        }
    }
}
__device__ __forceinline__ void retc_half(f32x16 (&acc)[4], int hf, bool has_state, const bf16_t* su, unsigned s_l, const bf16_t* hNu, unsigned q_l, float qd,
                                          const bf16_t* vu, unsigned v_l, const bf16x8 p0, const bf16x8 p1, const bf16x8 p2, const bf16x8 p3) {
#pragma unroll
    for (int e = 0; e < 4; ++e) acc[e] = zero16();
    if (has_state) {
#pragma unroll 2
        for (int ks = 0; ks < 16; ++ks) {
            const bf16x8 qf = ldf(hNu + 2048 + 16 * ks, q_l);
#pragma unroll
            for (int e = 0; e < 4; ++e) { const bf16x8 af = ldf(su + (4 * hf + e) * 8192 + 16 * ks, s_l); acc[e] = MFMA32(af, qf, acc[e]); }
            asm volatile("" ::: "memory");
        }
#pragma unroll
        for (int e = 0; e < 4; ++e) acc[e] = acc[e] * qd;
    }
#pragma unroll
    for (int e = 0; e < 4; ++e) {
        const bf16_t* ve = vu + (size_t)(4 * hf + e) * 32 * TOK;
        const bf16x8 v0 = ldf(ve, v_l), v1 = ldf(ve + 16, v_l), v2 = ldf(ve + 32, v_l), v3 = ldf(ve + 48, v_l);
        acc[e] = MFMA32(v0, p0, acc[e]); acc[e] = MFMA32(v1, p1, acc[e]); acc[e] = MFMA32(v2, p2, acc[e]); acc[e] = MFMA32(v3, p3, acc[e]);
        if (e & 1) asm volatile("" ::: "memory");
    }
}
__device__ __forceinline__ void retc_wave(bf16_t* hN, const bf16_t* __restrict__ hT, const bf16_t* __restrict__ ST, const float* __restrict__ gng, const float* __restrict__ gnb, int task, int lane) {
    asm volatile("" : "+v"(lane));
    const int r32 = lane & 31, hi = lane >> 5;
    const int half = task & 1, c = (task >> 1) & 63, bh = task >> 7, h = bh & 3, b = bh >> 2;
    const size_t tok0 = (size_t)b * SEQ + 64 * c;
    const int nl = 32 * half + r32;
    const float lg2 = lg2gamma(h);
    bf16_t* hNu = hN + tok0 * 4096 + h * 256;
    const unsigned q_l = (unsigned)(nl * 4096 + 8 * hi) * 2u;
    const unsigned k_l = (unsigned)(sig32(r32) * 4096 + 8 * hi) * 2u;
    const unsigned g_l = (unsigned)(nl * 4096 + 4 * hi) * 2u;
    bf16x8 p0, p1, p2, p3;
    {
        f32x16 s0 = zero16(), s1 = zero16();
#pragma unroll 2
        for (int ks = 0; ks < 16; ++ks) {
            const bf16x8 qf = ldf(hNu + 2048 + 16 * ks, q_l);
            const bf16x8 k0 = ldf(hNu + 3072 + 16 * ks, k_l), k1 = ldf(hNu + 3072 + 32 * 4096 + 16 * ks, k_l);
            s0 = MFMA32(k0, qf, s0); s1 = MFMA32(k1, qf, s1);
            if ((ks & 1) == 1) asm volatile("" ::: "memory");
        }
#pragma unroll
        for (int i = 0; i < 16; ++i) {
            const int m0 = 16 * (i >> 3) + 8 * hi + (i & 7);
            s0[i] *= __builtin_amdgcn_exp2f(lg2 * fabsf((float)(nl - m0)));
            s1[i] *= __builtin_amdgcn_exp2f(lg2 * fabsf((float)(nl - m0 - 32)));
        }
        p0 = pack_half(s0, 0); p1 = pack_half(s0, 1); p2 = pack_half(s1, 0); p3 = pack_half(s1, 1);
    }
    const bf16_t* su = ST + ((size_t)(bh * 64 + c) << 16);
    const unsigned s_l = (unsigned)(r32 * 256 + 8 * hi) * 2u;
    const float qd = __builtin_amdgcn_exp2f(lg2 * (float)(nl + 1));
    const bf16_t* vu = hT + (size_t)(1024 + h * 256) * TOK + tok0;
    const unsigned v_l = (unsigned)(r32 * TOK + 8 * hi) * 2u;
    float s = 0.f, q = 0.f;
    unsigned pa[32];
    {
        f32x16 acc[4];
        retc_half(acc, 0, c > 0, su, s_l, hNu, q_l, qd, vu, v_l, p0, p1, p2, p3);
#pragma unroll
        for (int e = 0; e < 4; ++e)
#pragma unroll
            for (int i = 0; i < 16; i += 2) { const float x0 = acc[e][i], x1 = acc[e][i + 1]; s += x0 + x1; q += x0 * x0 + x1 * x1; pa[8 * e + (i >> 1)] = pk2(x0, x1); }
    }
    f32x16 acc[4];
    retc_half(acc, 1, c > 0, su, s_l, hNu, q_l, qd, vu, v_l, p0, p1, p2, p3);
#pragma unroll
    for (int e = 0; e < 4; ++e)
#pragma unroll
        for (int i = 0; i < 16; ++i) { s += acc[e][i]; q += acc[e][i] * acc[e][i]; }
    s += shx(s, 32, lane); q += shx(q, 32, lane);
    const float mu = s * (1.0f / 256.0f);
    const float rstd = rsqrtf(fmaxf(q * (1.0f / 256.0f) - mu * mu, 0.f) + 1e-5f);
    const float* gg = gng + h * 256 + 4 * hi; const float* gb = gnb + h * 256 + 4 * hi;
#pragma unroll
    for (int e = 0; e < 8; ++e)
#pragma unroll
        for (int a = 0; a < 4; ++a) {
            const int e0 = 32 * e + 8 * a;
            const f32x4 g4 = *(const f32x4*)(gg + e0), b4 = *(const f32x4*)(gb + e0);
            const u32x2 rw = ld8(hNu + 1024 + e0, g_l);
            const float r0 = bf_lo(rw.x), r1 = bf_hi(rw.x), r2 = bf_lo(rw.y), r3 = bf_hi(rw.y);
            float x[4];
            if (e < 4) { const unsigned w0 = pa[8 * e + 2 * a], w1 = pa[8 * e + 2 * a + 1]; x[0] = bf_lo(w0); x[1] = bf_hi(w0); x[2] = bf_lo(w1); x[3] = bf_hi(w1); }
            else { x[0] = acc[e & 3][4 * a]; x[1] = acc[e & 3][4 * a + 1]; x[2] = acc[e & 3][4 * a + 2]; x[3] = acc[e & 3][4 * a + 3]; }
            float y[4];
#pragma unroll
            for (int j = 0; j < 4; ++j) y[j] = (x[j] - mu) * rstd * g4[j] + b4[j];
            y[0] *= r0 * __builtin_amdgcn_rcpf(1.0f + __builtin_amdgcn_exp2f(-1.4426950408889634f * r0));
            y[1] *= r1 * __builtin_amdgcn_rcpf(1.0f + __builtin_amdgcn_exp2f(-1.4426950408889634f * r1));
            y[2] *= r2 * __builtin_amdgcn_rcpf(1.0f + __builtin_amdgcn_exp2f(-1.4426950408889634f * r2));
            y[3] *= r3 * __builtin_amdgcn_rcpf(1.0f + __builtin_amdgcn_exp2f(-1.4426950408889634f * r3));
            u32x2 w; w.x = pk2(y[0], y[1]); w.y = pk2(y[2], y[3]);
            st8(hNu + 1024 + e0, g_l, w);
            if (a & 1) asm volatile("" ::: "memory");
        }
}
__device__ __forceinline__ void attn_wave(const bf16_t* __restrict__ Q, const bf16_t* __restrict__ Kn, const bf16_t* __restrict__ KR, const bf16_t* __restrict__ VT, bf16_t* O, int b, int h, int qg, int lane) {
    asm volatile("" : "+v"(lane));
    const int r32 = lane & 31, hi = lane >> 5;
    const size_t n0 = (size_t)b * SEQ + 32 * qg;
    bf16x8 qf[12];
    { const bf16_t* qu = Q + n0 * 1536 + h * 192; const unsigned q_l = (unsigned)(r32 * 1536 + 8 * hi) * 2u;
#pragma unroll
      for (int ks = 0; ks < 12; ++ks) qf[ks] = ldf(qu + 16 * ks, q_l); }
    f32x16 o[4];
#pragma unroll
    for (int d = 0; d < 4; ++d) o[d] = zero16();
    float mrun = -1e30f, l = 0.f;
    const int nt = (qg >> 1) + 1;
    const int sg = sig32(r32);
    const bf16_t* ku = Kn + (size_t)b * SEQ * 1024 + h * 128;
    const bf16_t* ru = KR + (size_t)b * SEQ * 64;
    const bf16_t* vu = VT + (size_t)h * 128 * TOK + (size_t)b * SEQ;
    const unsigned k_l = (unsigned)(sg * 1024 + 8 * hi) * 2u, r_l = (unsigned)(sg * 64 + 8 * hi) * 2u, v_l = (unsigned)(r32 * TOK + 8 * hi) * 2u;
    for (int kt = 0; kt < nt; ++kt) {
        f32x16 s0 = zero16(), s1 = zero16();
        const bf16_t* k0 = ku + (size_t)kt * 64 * 1024; const bf16_t* r0 = ru + (size_t)kt * 64 * 64;
#pragma unroll
        for (int ks = 0; ks < 8; ++ks) {
            const bf16x8 a0 = ldf(k0 + 16 * ks, k_l), a1 = ldf(k0 + 32 * 1024 + 16 * ks, k_l);
            s0 = MFMA32(a0, qf[ks], s0); s1 = MFMA32(a1, qf[ks], s1);
            if ((ks & 3) == 3) asm volatile("" ::: "memory");
        }
#pragma unroll
        for (int ks = 0; ks < 4; ++ks) {
            const bf16x8 a0 = ldf(r0 + 16 * ks, r_l), a1 = ldf(r0 + 32 * 64 + 16 * ks, r_l);
            s0 = MFMA32(a0, qf[8 + ks], s0); s1 = MFMA32(a1, qf[8 + ks], s1);
        }
        asm volatile("" ::: "memory");
        float mx = fmaxf(s0[0], s1[0]);
#pragma unroll
        for (int i = 1; i < 16; ++i) mx = fmaxf(mx, fmaxf(s0[i], s1[i]));
        mx = fmaxf(mx, shx(mx, 32, lane));
        const float mn = fmaxf(mrun, mx), al = __builtin_amdgcn_exp2f(mrun - mn); mrun = mn;
        float ps = 0.f;
#pragma unroll
        for (int i = 0; i < 16; ++i) { s0[i] = __builtin_amdgcn_exp2f(s0[i] - mn); s1[i] = __builtin_amdgcn_exp2f(s1[i] - mn); ps += s0[i] + s1[i]; }
        l = l * al + ps;
#pragma unroll
        for (int d = 0; d < 4; ++d) o[d] = o[d] * al;
        const bf16x8 p0 = pack_half(s0, 0), p1 = pack_half(s0, 1), p2 = pack_half(s1, 0), p3 = pack_half(s1, 1);
        const bf16_t* v0 = vu + kt * 64;
#pragma unroll
        for (int d = 0; d < 4; ++d) {
            const bf16_t* vd = v0 + (size_t)d * 32 * TOK;
            const bf16x8 f0 = ldf(vd, v_l), f1 = ldf(vd + 16, v_l), f2 = ldf(vd + 32, v_l), f3 = ldf(vd + 48, v_l);
            o[d] = MFMA32(f0, p0, o[d]); o[d] = MFMA32(f1, p1, o[d]); o[d] = MFMA32(f2, p2, o[d]); o[d] = MFMA32(f3, p3, o[d]);
            if (d & 1) asm volatile("" ::: "memory");
        }
    }
    l += shx(l, 32, lane);
    const float inv = 1.0f / l;
    bf16_t* ou = O + n0 * 4096 + h * 128; const unsigned o_l = (unsigned)(r32 * 4096 + 4 * hi) * 2u;
#pragma unroll
    for (int d = 0; d < 4; ++d)
#pragma unroll
        for (int a = 0; a < 4; ++a) {
            u32x2 w; w.x = pk2(o[d][4 * a] * inv, o[d][4 * a + 1] * inv); w.y = pk2(o[d][4 * a + 2] * inv, o[d][4 * a + 3] * inv);
            st8(ou + 32 * d + 8 * a, o_l, w);
        }
}
typedef __attribute__((address_space(4))) const char* kptr_t;
template <class T> __device__ __forceinline__ T* karg(kptr_t kp, int off) { typedef __attribute__((address_space(1))) T* Gp; return (T*)(*(const __attribute__((address_space(4))) Gp*)(kp + off)); }
struct Args { const float* in[19]; float* out; unsigned char* ws; int ph_lo, ph_hi; };

__global__ void __launch_bounds__(512, 2) mk_fwd(Args a) {
    extern __shared__ __attribute__((aligned(16))) unsigned char lds_raw[];
    LAS unsigned char* lds = (LAS unsigned char*)lds_raw;
    LAS unsigned char* lds_raw_las = lds;
    cg::this_grid().sync();
    if (threadIdx.x < 4) ((volatile LAS unsigned*)(lds_raw_las + 131072))[threadIdx.x] = 0u;
    __syncthreads();
    XcdBarrier bar = xcd_barrier_post((unsigned*)(a.ws + WS_BAR), (volatile LAS unsigned*)(lds_raw_las + 131072));
        const int G = gridDim.x, bx0 = blockIdx.x;
    const int NGW = G * 8;
    const int NTH = G * 512;
    const kptr_t kp0 = (kptr_t)__builtin_amdgcn_kernarg_segment_ptr();
#define KARG(T, off) (karg<T>(kp, (off)))
#define IN(i) KARG(const float, 8 * (i))
#define x_in IN(0)
#define positions ((const int*)IN(1))
#define xres KARG(float, 152)
#define ssb ((float*)(ws + WS_SS))
#define Win_t ((bf16_t*)(ws + WS_WIN))
#define Wuq_t ((bf16_t*)(ws + WS_WUQ))
#define Wkv_t ((bf16_t*)(ws + WS_WKV))
#define Wout_t ((bf16_t*)(ws + WS_WOUT))
#define Wgu_t ((bf16_t*)(ws + WS_WGU))
#define Wd_t ((bf16_t*)(ws + WS_WD))
#define cosT ((float*)(ws + WS_TAB))
#define sinT ((float*)(ws + WS_TAB) + (size_t)TOK * 128)
#define hN ((bf16_t*)(ws + WS_HN))
#define hT ((bf16_t*)(ws + WS_HT))
#define xb ((bf16_t*)(ws + WS_XB))
#define Qb ((bf16_t*)(ws + WS_Q))
#define KR ((bf16_t*)(ws + WS_KR))
#define ST ((bf16_t*)(ws + WS_ST))
#define Kn ((bf16_t*)(ws + WS_KN))
#define VT ((bf16_t*)(ws + WS_VT))
#define act ((bf16_t*)(ws + WS_ACT))
    int ph = 0;
#define PH_BEGIN if (a.ph_lo <= ph && ph < a.ph_hi) { kptr_t kp = kp0; asm volatile("" : "+s"(kp)); unsigned char* const ws = KARG(unsigned char, 160); int bx = bx0; asm volatile("" : "+s"(bx));
#define IDS int tid_ = threadIdx.x; asm volatile("" : "+v"(tid_)); const int lane = tid_ & 63; const int wave = __builtin_amdgcn_readfirstlane(tid_ >> 6); const int gw = wave * G + bx; LAS float* scr = (LAS float*)(lds + wave * 16384); const int gtid = bx * 512 + wave * 64 + lane; (void)scr; (void)gtid; (void)gw;
#define PH_END   if (ph + 1 < a.ph_hi) { XcdBarrier b2 = bar; asm volatile("" : "+s"(b2.bar)); xcd_barrier(b2); } } ++ph;

#define CVT_ATTN(l) do { \
        const float* w_in_l = IN(4) + (size_t)(l) * 2048 * 4928; const float* w_uq_l = IN(7) + (size_t)(l) * 512 * 1536; \
        const float* w_ukv_l = IN(8) + (size_t)(l) * 256 * 2048; const float* w_out_l = IN(11) + (size_t)(l) * 2048 * 2048; \
        const float* qng = IN(5) + (l) * 512; const float* kvng = IN(6) + (l) * 256; \
        for (int it = gw; it < 7616; it += NGW) { int r = it; \
            if (r < 4928) { cvt_item<0>(w_in_l, 2048, 4928, nullptr, Win_t, scr, r, lane); continue; } r -= 4928; \
            if (r < 384) { cvt_item<1>(w_uq_l, 512, 1536, qng, Wuq_t, scr, r, lane); continue; } r -= 384; \
            if (r < 256) { cvt_item<2>(w_ukv_l, 256, 2048, kvng, Wkv_t, scr, r, lane); continue; } r -= 256; \
            cvt_item<3>(w_out_l, 2048, 2048, nullptr, Wout_t, scr, r, lane); } \
        for (int i = gtid; i < 192 * 256; i += NTH) { const int rr = i >> 8, cc = i & 255; const int row = rr < 96 ? 800 + rr : 928 + (rr - 96); \
            unsigned z = 0u; asm volatile("" : "+v"(z)); *(u32x4*)(Win_t + (size_t)row * 2048 + cc * 8) = (u32x4){z, z, z, z}; } \
    } while (0)
#define CVT_FFN(l) do { \
        const float* w_g = IN(14) + (size_t)(l) * 2048 * 5632; const float* w_u = IN(15) + (size_t)(l) * 2048 * 5632; const float* w_d = IN(16) + (size_t)(l) * 5632 * 2048; \
        for (int it = gw; it < 3 * 5632; it += NGW) { int r = it; \
            if (r < 5632) { cvt_item<4>(w_g, 2048, 5632, nullptr, Wgu_t, scr, r, lane); continue; } r -= 5632; \
            if (r < 5632) { cvt_item<5>(w_u, 2048, 5632, nullptr, Wgu_t, scr, r, lane); continue; } r -= 5632; \
            cvt_item<3>(w_d, 5632, 2048, nullptr, Wd_t, scr, r, lane); } \
    } while (0)

    PH_BEGIN
        IDS
        for (int idx = gtid; idx < TOK * 128; idx += NTH) {
            const int t = idx >> 7, j = idx & 127;
            const float invf = __builtin_amdgcn_exp2f(-(float)j * (13.287712379549449f / 128.0f));
            const double rev = (double)positions[t] * (double)invf * 0.15915494309189535;
            const float fr = (float)(rev - __builtin_rint(rev));
            cosT[idx] = __builtin_amdgcn_cosf(fr); sinT[idx] = __builtin_amdgcn_sinf(fr);
        }
        for (int i = gtid; i < 4 * TOK; i += NTH) ssb[i] = 0.f;
#ifndef DIS_CVT
        CVT_ATTN(0);
#endif
#ifndef DIS_LN
        for (int m = gw; m < TOK; m += NGW) ln_row(x_in + (size_t)m * DM, xres + (size_t)m * DM, xb + (size_t)m * DM, IN(2), IN(3), lane);
#endif
    PH_END

    for (int l = 0; l < 2; ++l) {

        PH_BEGIN
            float* ssq = ssb + (size_t)l * 2 * TOK; float* sskv = ssq + TOK;
#ifndef DIS_G1
            { pg8::Gemm g{xb, Win_t, TOK, 4096, 2048, 2048, 2048}; pg8::StaticOrder S; S.init(TOK, 4096, G, bx);
              pg8::EpiIn E{hN, KR, ssq, sskv, cosT, sinT};
              pg8::gemm_phase<pg8::EpiIn, pg8::StaticOrder, PG8_ALIGN, PG8_SP2>(lds, g, S, E); }
#endif
#ifndef DIS_G2
            { pg8::Gemm g{Win_t + (size_t)4096 * 2048, xb, 2048, TOK, 2048, 2048, 2048}; pg8::StaticOrder S; S.init(2048, TOK, G, bx);
              pg8::EpiInT E{hT, cosT, sinT};
              pg8::gemm_phase<pg8::EpiInT, pg8::StaticOrder, PG8_ALIGN, PG8_SP2>(lds, g, S, E); }
#endif
        PH_END
        PH_BEGIN
            float* ssq = ssb + (size_t)l * 2 * TOK; float* sskv = ssq + TOK;
#ifndef DIS_G3
            { pg8::Gemm g{hN, Wuq_t, TOK, 1536, 512, 4096, 512}; pg8::StaticOrder S; S.init(TOK, 1536, G, bx);
              pg8::EpiQ E{Qb, ssq, cosT, sinT};
              pg8::gemm_phase<pg8::EpiQ, pg8::StaticOrder, PG8_ALIGN, PG8_SP2>(lds, g, S, E); }
#endif
#ifndef DIS_G4
            { pg8::Gemm g{hN + 512, Wkv_t, TOK, 1024, 256, 4096, 256}; pg8::StaticOrder S; S.init(TOK, 1024, G, bx);
              pg8::EpiK E{Kn, sskv};
              pg8::gemm_phase<pg8::EpiK, pg8::StaticOrder, PG8_ALIGN, PG8_SP2>(lds, g, S, E); }
#endif
#ifndef DIS_G5
            { pg8::Gemm g{Wkv_t + (size_t)1024 * 256, hN + 512, 1024, TOK, 256, 256, 4096}; pg8::StaticOrder S; S.init(1024, TOK, G, bx);
              pg8::EpiVT E{VT, sskv};
              pg8::gemm_phase<pg8::EpiVT, pg8::StaticOrder, PG8_ALIGN, PG8_SP2>(lds, g, S, E); }
#endif
#ifndef DIS_SCAN
            { IDS
            for (int wt = gw; wt < 1024; wt += NGW) scan_wave(hT, ST, wt, lane); }
#endif
        PH_END
        PH_BEGIN
            IDS
            for (int bt = bx; bt < 512; bt += G) {
                const int b2 = bt & 255, xcd = b2 & 7, y = b2 >> 3, bh = xcd * 4 + (y >> 3), q8 = y & 7;
                const int qb8 = bt < 256 ? q8 : 15 - q8;
#ifndef DIS_ATTN
                attn_wave(Qb, Kn, KR, VT, hN, bh >> 3, bh & 7, 8 * qb8 + wave, lane);
#endif
            }
#ifndef DIS_RETC
            for (int task = bx * 8 + wave; task < 2048; task += NGW) retc_wave(hN, hT, ST, IN(9) + l * 1024, IN(10) + l * 1024, task, lane);
#endif
        PH_END
        PH_BEGIN
#ifndef DIS_G6
            { pg8::Gemm g{hN, Wout_t, TOK, 2048, 2048, 4096, 2048}; pg8::StaticOrder S; S.init(TOK, 2048, G, bx);
              pg8::EpiRes E{xres};
              pg8::gemm_phase<pg8::EpiRes, pg8::StaticOrder, PG8_ALIGN, PG8_SP2>(lds, g, S, E); }
#endif
        PH_END
        PH_BEGIN
            IDS
#ifndef DIS_LN
            for (int m = gw; m < TOK; m += NGW) ln_row(xres + (size_t)m * DM, xres + (size_t)m * DM, xb + (size_t)m * DM, IN(12) + l * DM, IN(13) + l * DM, lane);
#endif
#ifndef DIS_CVT
            CVT_FFN(l);
#endif
        PH_END
        PH_BEGIN
#ifndef DIS_G7
            { pg8::Gemm g{xb, Wgu_t, TOK, 2 * DFF, 2048, 2048, 2048}; pg8::StaticOrder S; S.init(TOK, 2 * DFF, G, bx);
              pg8::EpiGU E{act};
              pg8::gemm_phase<pg8::EpiGU, pg8::StaticOrder, PG8_ALIGN, PG8_SP2>(lds, g, S, E); }
#endif
        PH_END
        PH_BEGIN
#ifndef DIS_G8
            { pg8::Gemm g{act, Wd_t, TOK, 2048, DFF, DFF, DFF}; pg8::StaticOrder S; S.init(TOK, 2048, G, bx);
              pg8::EpiRes E{xres};
              pg8::gemm_phase<pg8::EpiRes, pg8::StaticOrder, PG8_ALIGN, PG8_SP2>(lds, g, S, E); }
#endif
        PH_END
        PH_BEGIN
            IDS
#ifndef DIS_LN
            for (int m = gw; m < TOK; m += NGW) ln_row(xres + (size_t)m * DM, xres + (size_t)m * DM, xb + (size_t)m * DM, IN(17) + l * DM, IN(18) + l * DM, lane);
#endif
#ifndef DIS_CVT
            if (l == 0) CVT_ATTN(1);
#endif
        PH_END
    }
}

#undef IN
#undef KARG
#undef x_in
#undef positions
#undef xres
#undef ssb
#undef Win_t
#undef Wuq_t
#undef Wkv_t
#undef Wout_t
#undef Wgu_t
#undef Wd_t
#undef cosT
#undef sinT
#undef hN
#undef hT
#undef xb
#undef Qb
#undef KR
#undef ST
#undef Kn
#undef VT
#undef act
#ifndef MK_SPLIT
#define MK_SPLIT 0
#endif
extern "C" void kernel_launch(void* const* d_in, const int* in_sizes, int n_in, void* d_out, int out_size, void* d_ws, size_t ws_size, hipStream_t stream) {
    static int grid = 0;
    if (grid == 0) {
        if (n_in != 19 || out_size != TOK * DM || ws_size < WS_END) { fprintf(stderr, "kernel_launch: unexpected shapes (n_in %d, out %d, ws %zu)\n", n_in, out_size, ws_size); grid = -1; return; }
        int dev = 0, cus = 0, per_cu = 0;
        (void)hipGetDevice(&dev); (void)hipDeviceGetAttribute(&cus, hipDeviceAttributeMultiprocessorCount, dev);
        if (hipFuncSetAttribute((const void*)mk_fwd, hipFuncAttributeMaxDynamicSharedMemorySize, LDS_BYTES) != hipSuccess) { fprintf(stderr, "kernel_launch: hipFuncSetAttribute failed\n"); grid = -1; return; }
        if (hipOccupancyMaxActiveBlocksPerMultiprocessor(&per_cu, (const void*)mk_fwd, 512, LDS_BYTES) != hipSuccess || per_cu < 1) { fprintf(stderr, "kernel_launch: occupancy query says %d\n", per_cu); per_cu = 1; }
        (void)hipGetLastError();
        grid = cus * 1;
        if (grid <= 0) grid = 256;
    }
    if (grid < 0) return;
    if (hipMemsetAsync((char*)d_ws + WS_BAR, 0, XCD_BAR_WORDS * 4, stream) != hipSuccess) { fprintf(stderr, "kernel_launch: memset failed\n"); return; }
    Args a{};
    for (int i = 0; i < 19; ++i) a.in[i] = (const float*)d_in[i];
    a.out = (float*)d_out; a.ws = (unsigned char*)d_ws;
#if MK_SPLIT
    for (int p = 0; p < NPH; ++p) { a.ph_lo = p; a.ph_hi = p + 1; void* args[] = {&a};
        hipError_t e = hipLaunchCooperativeKernel((const void*)mk_fwd, dim3(grid), dim3(512), args, LDS_BYTES, stream);
        if (e != hipSuccess) { fprintf(stderr, "launch %d failed: %s\n", p, hipGetErrorString(e)); break; } }
#else
    a.ph_lo = 0; a.ph_hi = NPH; void* args[] = {&a};
    hipError_t e = hipLaunchCooperativeKernel((const void*)mk_fwd, dim3(grid), dim3(512), args, LDS_BYTES, stream);
    if (e != hipSuccess) fprintf(stderr, "cooperative launch failed: %s (grid %d)\n", hipGetErrorString(e), grid);
#endif
}
```

```cpp
#include <hip/hip_runtime.h>
#include <hip/hip_cooperative_groups.h>
#include <cstdio>
#include <cstdint>
namespace cg = cooperative_groups;

typedef float f32x16 __attribute__((ext_vector_type(16)));
typedef unsigned u32x2 __attribute__((ext_vector_type(2)));
typedef float f32x2_t __attribute__((ext_vector_type(2)));
typedef __bf16 bf16x2_t __attribute__((ext_vector_type(2)));
__device__ __forceinline__ unsigned pk2(float lo, float hi) { f32x2_t v = {lo, hi}; bf16x2_t b = __builtin_convertvector(v, bf16x2_t); return __builtin_bit_cast(unsigned, b); }
__device__ __forceinline__ float bf_lo(unsigned w) { return __uint_as_float(w << 16); }
__device__ __forceinline__ float bf_hi(unsigned w) { return __uint_as_float(w & 0xffff0000u); }

constexpr int TOK = 16384, SEQ = 4096, DM = 2048, DFF = 5632;
constexpr float ALPHA = 1.4142135623730951f;
constexpr float QSCALE = 0.10411754627697264f;
__device__ __forceinline__ float lg2gamma(int h) { return h == 0 ? -0.04580368961312479f : h == 1 ? -0.02272007650008353f : h == 2 ? -0.011315313227834146f : -0.005646563141142063f; }
__device__ __forceinline__ float shx(float v, int mask, int lane) { return __int_as_float(__builtin_amdgcn_ds_bpermute((lane ^ mask) << 2, __float_as_int(v))); }
namespace pg8 {
#define PG8_LAS __attribute__((address_space(3)))
typedef unsigned short bf16_t;
typedef short bf16x8 __attribute__((ext_vector_type(8)));
typedef float f32x4 __attribute__((ext_vector_type(4)));
typedef unsigned u32x4 __attribute__((ext_vector_type(4)));
constexpr int BM = 256, BK = 64, HALF = 128, HTB = HALF * BK * 2  , STAGE_BYTES = 8 * HTB, NXCD = 8, WGM = 8;

__host__ __device__ __forceinline__ int lds_byte(int r, int c) { const int st = (r >> 4) * 2 + (c >> 5), rr = r & 15, cc = c & 31, ob = rr * 64 + cc * 2; return st * 1024 + (ob ^ (((ob >> 9) & 1) << 5)); }
__host__ __device__ __forceinline__ void stage_rc(int b, int& R, int& C) { const int st = b / 1024, sb = b % 1024, swz = sb ^ (((sb >> 9) & 1) << 5); R = (st >> 1) * 16 + swz / 64; C = (st & 1) * 32 + (swz % 64) / 2; }
__host__ __device__ __forceinline__ int perm32(int rho) { const int n = rho >> 4, i = rho & 15; return 8 * (i >> 2) + 4 * n + (i & 3); }

struct Unit { int pm, pn; };
struct Gemm { const bf16_t* A; const bf16_t* Bt; int M, N, K, lda, ldb; };

struct StaticOrder {
    int nM, nN, nwg, G, c;
    __host__ __device__ void init(int M, int N, int G_, int c_) { nM = M / BM; nN = N / BM; nwg = nM * nN; G = G_; c = c_; }
    __host__ __device__ bool next(int i, Unit& u) const {
        const long L = (long)i * G + c; if (L >= nwg) return false;
        int wgid = (int)L; { const int q = nwg / NXCD, r = nwg % NXCD, xcd = wgid % NXCD, off = wgid / NXCD; wgid = (xcd < r ? xcd * (q + 1) : r * (q + 1) + (xcd - r) * q) + off; }
        const int nig = WGM * nN, gid = wgid / nig, fm = gid * WGM, gsz = (nM - fm) < WGM ? (nM - fm) : WGM;
        u.pm = fm + ((wgid % nig) % gsz); u.pn = (wgid % nig) / gsz; return true;
    }
    __device__ __forceinline__ void a_ready(const Unit&) const {}
    __device__ __forceinline__ void done(const Unit&) const {}
};
__device__ __forceinline__ unsigned cvt_pk_bf16(float lo, float hi) { return pk2(lo, hi); }
__device__ __forceinline__ u32x4 pack8(const f32x4 a, const f32x4 b) { u32x4 w; w.x = pk2(a[0], a[1]); w.y = pk2(a[2], a[3]); w.z = pk2(b[0], b[1]); w.w = pk2(b[2], b[3]); return w; }
__device__ __forceinline__ float dot4(const f32x4 a) { return (a[0] * a[0] + a[1] * a[1]) + (a[2] * a[2] + a[3] * a[3]); }

struct EpiIn {
    static constexpr bool PERM = true, AFTER_DRAIN = false;
    bf16_t* hN; bf16_t* kr; float* ssq; float* sskv; const float* cosT; const float* sinT;
    __device__ __forceinline__ void operator()(const f32x4 (&acc)[2][2][4][2], const Unit& u, int wr, int wc, int fr, int fq) const {
        { int t_ = threadIdx.x; asm volatile("" : "+v"(t_)); fr = t_ & 15; fq = (t_ >> 4) & 3; }
        const int pn = u.pn, row0 = u.pm * BM + wr * 64 + fr, cl = wc * 32 + 8 * fq;
        if (pn >= 8) {
            const float sc = pn < 12 ? 0.0625f : 1.0f;
#pragma unroll
            for (int ai = 0; ai < 2; ++ai)
#pragma unroll
                for (int m = 0; m < 4; ++m) {
                    const int row = row0 + ai * HALF + m * 16;
                    const float* cp = cosT + (size_t)row * 128 + cl; const float* sp = sinT + (size_t)row * 128 + cl;
                    const f32x4 c0 = *(const f32x4*)cp, c1 = *(const f32x4*)(cp + 4), s0 = *(const f32x4*)sp, s1 = *(const f32x4*)(sp + 4);
                    const f32x4 a0 = acc[ai][0][m][0], a1 = acc[ai][0][m][1], b0 = acc[ai][1][m][0], b1 = acc[ai][1][m][1];
                    const f32x4 o10 = (a0 * c0 - b0 * s0) * sc, o11 = (a1 * c1 - b1 * s1) * sc, o20 = (b0 * c0 + a0 * s0) * sc, o21 = (b1 * c1 + a1 * s1) * sc;
                    bf16_t* p = hN + (size_t)row * 4096 + pn * 256 + cl;
                    *(u32x4*)p = pack8(o10, o11); *(u32x4*)(p + 128) = pack8(o20, o21); asm volatile("" ::: "memory");
                }
        } else if (pn == 3) {
            if (wc == 0) {
#pragma unroll
                for (int ai = 0; ai < 2; ++ai)
#pragma unroll
                    for (int m = 0; m < 4; ++m) {
                        const int row = row0 + ai * HALF + m * 16;
                        const float* cp = cosT + (size_t)row * 128 + 32 * fq; const float* sp = sinT + (size_t)row * 128 + 32 * fq;
                        f32x4 c0, c1, s0, s1;
#pragma unroll
                        for (int j = 0; j < 4; ++j) { c0[j] = cp[4 * j]; c1[j] = cp[16 + 4 * j]; s0[j] = sp[4 * j]; s1[j] = sp[16 + 4 * j]; }
                        const f32x4 a0 = acc[ai][0][m][0], a1 = acc[ai][0][m][1], b0 = acc[ai][1][m][0], b1 = acc[ai][1][m][1];
                        const f32x4 o10 = a0 * c0 - b0 * s0, o11 = a1 * c1 - b1 * s1, o20 = b0 * c0 + a0 * s0, o21 = b1 * c1 + a1 * s1;
                        bf16_t* p = kr + (size_t)row * 64 + 8 * fq;
                        *(u32x4*)p = pack8(o10, o11); *(u32x4*)(p + 32) = pack8(o20, o21); asm volatile("" ::: "memory");
                    }
            }
        } else {
            float* ss = pn < 2 ? ssq : sskv;
#pragma unroll
            for (int ai = 0; ai < 2; ++ai)
#pragma unroll
                for (int m = 0; m < 4; ++m) {
                    const int row = row0 + ai * HALF + m * 16; float s = 0.f;
#pragma unroll
                    for (int bj = 0; bj < 2; ++bj) {
                        const f32x4 v0 = acc[ai][bj][m][0], v1 = acc[ai][bj][m][1];
                        *(u32x4*)(hN + (size_t)row * 4096 + pn * 256 + bj * HALF + cl) = pack8(v0, v1);
                        s += dot4(v0) + dot4(v1);
                    }
                    if (pn < 3) { s += shx(s, 16, fq * 16 + fr); s += shx(s, 32, fq * 16 + fr); if (fq == 0) atomicAdd(ss + row, s); }
                }
        }
    }
};
struct EpiInT {
    static constexpr bool PERM = true, AFTER_DRAIN = false;
    bf16_t* hT; const float* cosT; const float* sinT;
    __device__ __forceinline__ void operator()(const f32x4 (&acc)[2][2][4][2], const Unit& u, int wr, int wc, int fr, int fq) const {
        { int t_ = threadIdx.x; asm volatile("" : "+v"(t_)); fr = t_ & 15; fq = (t_ >> 4) & 3; }
        const int pm = u.pm, tok0 = u.pn * BM + wc * 32 + 8 * fq;
        if (pm < 4) {
            const float lg2 = lg2gamma(pm);
#pragma unroll
            for (int m = 0; m < 4; ++m) {
                const int i = wr * 64 + m * 16 + fr;
#pragma unroll
                for (int bj = 0; bj < 2; ++bj) {
                    const int tok = tok0 + bj * HALF;
                    f32x4 o1[2], o2[2];
#pragma unroll
                    for (int n = 0; n < 2; ++n)
#pragma unroll
                        for (int j = 0; j < 4; ++j) {
                            const int t = tok + 4 * n + j;
                            const float c = cosT[(size_t)t * 128 + i], s = sinT[(size_t)t * 128 + i];
                            const float dec = __builtin_amdgcn_exp2f(lg2 * (float)(63 - (t & 63)));
                            const float t1 = acc[0][bj][m][n][j], t2 = acc[1][bj][m][n][j];
                            o1[n][j] = (t1 * c - t2 * s) * dec; o2[n][j] = (t2 * c + t1 * s) * dec;
                        }
                    *(u32x4*)(hT + (size_t)(pm * 256 + i) * TOK + tok) = pack8(o1[0], o1[1]);
                    *(u32x4*)(hT + (size_t)(pm * 256 + 128 + i) * TOK + tok) = pack8(o2[0], o2[1]); asm volatile("" ::: "memory");
                }
            }
        } else {
#pragma unroll
            for (int ai = 0; ai < 2; ++ai)
#pragma unroll
                for (int m = 0; m < 4; ++m) {
                    const int r = pm * 256 + ai * HALF + wr * 64 + m * 16 + fr;
#pragma unroll
                    for (int bj = 0; bj < 2; ++bj) *(u32x4*)(hT + (size_t)r * TOK + tok0 + bj * HALF) = pack8(acc[ai][bj][m][0], acc[ai][bj][m][1]);
                }
        }
    }
};
struct EpiQ {
    static constexpr bool PERM = true, AFTER_DRAIN = false;
    bf16_t* Q; const float* ssq; const float* cosT; const float* sinT;
    __device__ __forceinline__ void operator()(const f32x4 (&acc)[2][2][4][2], const Unit& u, int wr, int wc, int fr, int fq) const {
        { int t_ = threadIdx.x; asm volatile("" : "+v"(t_)); fr = t_ & 15; fq = (t_ >> 4) & 3; }
        const int pn = u.pn, row0 = u.pm * BM + wr * 64 + fr;
#pragma unroll
        for (int ai = 0; ai < 2; ++ai)
#pragma unroll
            for (int m = 0; m < 4; ++m) {
                const int row = row0 + ai * HALF + m * 16;
                const float rs = rsqrtf(ssq[row] * (1.0f / 512.0f) + 1e-6f) * QSCALE;
                if (pn < 4) {
#pragma unroll
                    for (int bj = 0; bj < 2; ++bj)
                        *(u32x4*)(Q + (size_t)row * 1536 + (2 * pn + bj) * 192 + wc * 32 + 8 * fq) = pack8(acc[ai][bj][m][0] * rs, acc[ai][bj][m][1] * rs);
                } else {
                    const float* cp = cosT + (size_t)row * 128 + 32 * fq; const float* sp = sinT + (size_t)row * 128 + 32 * fq;
                    f32x4 c0, c1, s0, s1;
#pragma unroll
                    for (int j = 0; j < 4; ++j) { c0[j] = cp[4 * j]; c1[j] = cp[16 + 4 * j]; s0[j] = sp[4 * j]; s1[j] = sp[16 + 4 * j]; }
                    const f32x4 a0 = acc[ai][0][m][0] * rs, a1 = acc[ai][0][m][1] * rs, b0 = acc[ai][1][m][0] * rs, b1 = acc[ai][1][m][1] * rs;
                    const f32x4 o10 = a0 * c0 - b0 * s0, o11 = a1 * c1 - b1 * s1, o20 = b0 * c0 + a0 * s0, o21 = b1 * c1 + a1 * s1;
                    bf16_t* p = Q + (size_t)row * 1536 + (4 * (pn - 4) + wc) * 192 + 128 + 8 * fq;
                    *(u32x4*)p = pack8(o10, o11); *(u32x4*)(p + 32) = pack8(o20, o21); asm volatile("" ::: "memory");
                }
            }
    }
};
struct EpiK {
    static constexpr bool PERM = true, AFTER_DRAIN = false;
    bf16_t* Kn; const float* sskv;
    __device__ __forceinline__ void operator()(const f32x4 (&acc)[2][2][4][2], const Unit& u, int wr, int wc, int fr, int fq) const {
        { int t_ = threadIdx.x; asm volatile("" : "+v"(t_)); fr = t_ & 15; fq = (t_ >> 4) & 3; }
        const int row0 = u.pm * BM + wr * 64 + fr, col0 = u.pn * BM + wc * 32 + 8 * fq;
#pragma unroll
        for (int ai = 0; ai < 2; ++ai)
#pragma unroll
            for (int m = 0; m < 4; ++m) {
                const int row = row0 + ai * HALF + m * 16;
                const float rs = rsqrtf(sskv[row] * (1.0f / 256.0f) + 1e-6f);
#pragma unroll
                for (int bj = 0; bj < 2; ++bj) *(u32x4*)(Kn + (size_t)row * 1024 + col0 + bj * HALF) = pack8(acc[ai][bj][m][0] * rs, acc[ai][bj][m][1] * rs);
            }
    }
};
struct EpiVT {
    static constexpr bool PERM = true, AFTER_DRAIN = false;
    bf16_t* VT; const float* sskv;
    __device__ __forceinline__ void operator()(const f32x4 (&acc)[2][2][4][2], const Unit& u, int wr, int wc, int fr, int fq) const {
        { int t_ = threadIdx.x; asm volatile("" : "+v"(t_)); fr = t_ & 15; fq = (t_ >> 4) & 3; }
        const int tok0 = u.pn * BM + wc * 32 + 8 * fq;
        f32x4 rs[2][2];
#pragma unroll
        for (int bj = 0; bj < 2; ++bj)
#pragma unroll
            for (int n = 0; n < 2; ++n) { const f32x4 s = *(const f32x4*)(sskv + tok0 + bj * HALF + 4 * n);
#pragma unroll
                for (int j = 0; j < 4; ++j) rs[bj][n][j] = rsqrtf(s[j] * (1.0f / 256.0f) + 1e-6f); }
#pragma unroll
        for (int ai = 0; ai < 2; ++ai)
#pragma unroll
            for (int m = 0; m < 4; ++m) {
                const int r = u.pm * BM + ai * HALF + wr * 64 + m * 16 + fr;
#pragma unroll
                for (int bj = 0; bj < 2; ++bj) *(u32x4*)(VT + (size_t)r * TOK + tok0 + bj * HALF) = pack8(acc[ai][bj][m][0] * rs[bj][0], acc[ai][bj][m][1] * rs[bj][1]);
            }
    }
};
struct EpiRes {
    static constexpr bool PERM = true, AFTER_DRAIN = false;
    float* x;
    __device__ __forceinline__ void operator()(const f32x4 (&acc)[2][2][4][2], const Unit& u, int wr, int wc, int fr, int fq) const {
        { int t_ = threadIdx.x; asm volatile("" : "+v"(t_)); fr = t_ & 15; fq = (t_ >> 4) & 3; }
        const int row0 = u.pm * BM + wr * 64 + fr, col0 = u.pn * BM + wc * 32 + 8 * fq;
#pragma unroll
        for (int ai = 0; ai < 2; ++ai)
#pragma unroll
            for (int m = 0; m < 4; ++m) {
                float* rp = x + (size_t)(row0 + ai * HALF + m * 16) * DM + col0;
#pragma unroll
                for (int bj = 0; bj < 2; ++bj)
#pragma unroll
                    for (int n = 0; n < 2; ++n) { f32x4* p = (f32x4*)(rp + bj * HALF + 4 * n); *p = *p * ALPHA + acc[ai][bj][m][n]; }
                asm volatile("" ::: "memory");
            }
    }
};
struct EpiGU {
    static constexpr bool PERM = true, AFTER_DRAIN = false;
    bf16_t* act;
    __device__ __forceinline__ void operator()(const f32x4 (&acc)[2][2][4][2], const Unit& u, int wr, int wc, int fr, int fq) const {
        { int t_ = threadIdx.x; asm volatile("" : "+v"(t_)); fr = t_ & 15; fq = (t_ >> 4) & 3; }
        const int row0 = u.pm * BM + wr * 64 + fr, col0 = u.pn * 128 + wc * 16 + 4 * fq;
#pragma unroll
        for (int ai = 0; ai < 2; ++ai)
#pragma unroll
            for (int m = 0; m < 4; ++m) {
                bf16_t* rp = act + (size_t)(row0 + ai * HALF + m * 16) * DFF + col0;
#pragma unroll
                for (int bj = 0; bj < 2; ++bj) {
                    const f32x4 g = acc[ai][bj][m][0], up = acc[ai][bj][m][1]; f32x4 o;
#pragma unroll
                    for (int j = 0; j < 4; ++j) o[j] = g[j] * __builtin_amdgcn_rcpf(1.0f + __builtin_amdgcn_exp2f(-1.4426950408889634f * g[j])) * up[j];
                    u32x2 w; w.x = pk2(o[0], o[1]); w.y = pk2(o[2], o[3]);
                    *(u32x2*)(rp + bj * 64) = w;
                }
            }
    }
};

template <class Epi, class Sched, bool ALIGN_EPI = false, bool SP2 = false>
__device__ __forceinline__ void gemm_phase(PG8_LAS unsigned char* lds, const Gemm g, const Sched& S, const Epi& E) {
    int tid_ = threadIdx.x; asm volatile("" : "+v"(tid_));
    const int tid = tid_, wid = __builtin_amdgcn_readfirstlane(tid >> 6), lane = tid & 63, wr = wid >> 2, wc = wid & 3, fr = lane & 15, fq = lane >> 4;
    const int K = g.K, nt = K / BK;
    unsigned voffA[2], voffB[2];
#pragma unroll
    for (int i = 0; i < 2; ++i) { int R, C; stage_rc(tid * 16 + i * 8192, R, C); const int Rb = Epi::PERM ? ((R & ~31) + perm32(R & 31)) : R;
        voffA[i] = (unsigned)(R * g.lda + C) * 2u; voffB[i] = (unsigned)(Rb * g.ldb + C) * 2u; }
    const size_t kstep = (size_t)(BK * 2);
    const size_t hstepA = (size_t)HALF * g.lda * 2, hstepB = (size_t)HALF * g.ldb * 2;
    const size_t tstepA = 2 * hstepA, tstepB = 2 * hstepB;
    const unsigned ldsw = (unsigned)wid * 1024u;
    const int aoff = lds_byte(wr * 64 + fr, fq * 8), boff = lds_byte(wc * 32 + fr, fq * 8);
#define PG8_SA(b, h) (((b) * 2 + (h)) * HTB)
#define PG8_SB(b, h) ((4 + (b) * 2 + (h)) * HTB)
#define PG8_STAGE(bufoff, gbase, voff) do { _Pragma("unroll") for (int _i = 0; _i < 2; ++_i) \
        __builtin_amdgcn_global_load_lds((const unsigned*)((const char*)(gbase) + (voff)[_i]), (PG8_LAS unsigned*)(lds + (bufoff) + ldsw + _i * 8192), 16, 0, 0); } while (0)
#define PG8_LDA(dst, b, h) do { _Pragma("unroll") for (int m = 0; m < 4; ++m) _Pragma("unroll") for (int k = 0; k < 2; ++k) dst[m][k] = *(const PG8_LAS bf16x8*)(lds + PG8_SA(b, h) + aoff + m * 2048 + k * 1024); } while (0)
#define PG8_LDB(dst, b, h) do { _Pragma("unroll") for (int n = 0; n < 2; ++n) _Pragma("unroll") for (int k = 0; k < 2; ++k) dst[n][k] = *(const PG8_LAS bf16x8*)(lds + PG8_SB(b, h) + boff + n * 2048 + k * 1024); } while (0)
#define PG8_MMA(ai, bj, At, Bt) do { __builtin_amdgcn_s_setprio(1); _Pragma("unroll") for (int m = 0; m < 4; ++m) _Pragma("unroll") for (int n = 0; n < 2; ++n) _Pragma("unroll") for (int k = 0; k < 2; ++k) \
        acc[ai][bj][m][n] = __builtin_amdgcn_mfma_f32_16x16x32_bf16(Bt[n][k], At[m][k], acc[ai][bj][m][n], 0, 0, 0); __builtin_amdgcn_s_setprio(0); } while (0)
#define PG8_WAIT_V(n) asm volatile("s_waitcnt vmcnt(" #n ")" ::: "memory")
#define PG8_WAIT_L(n) asm volatile("s_waitcnt lgkmcnt(" #n ")" ::: "memory")
#define PG8_BAR __builtin_amdgcn_s_barrier()
#define PG8_SCHED __builtin_amdgcn_sched_barrier(0)
    Unit cur, nxt; int ui = 0;
    if (!S.next(0, cur)) return;
    f32x4 acc[2][2][4][2];
#pragma unroll
    for (int a = 0; a < 2; ++a)
#pragma unroll
        for (int b = 0; b < 2; ++b)
#pragma unroll
            for (int m = 0; m < 4; ++m)
#pragma unroll
                for (int n = 0; n < 2; ++n) acc[a][b][m][n] = (f32x4){0.f, 0.f, 0.f, 0.f};
    bf16x8 At[4][2], B0[2][2], B1[2][2];
    const char* cA = (const char*)g.A + (size_t)cur.pm * tstepA; const char* cB = (const char*)g.Bt + (size_t)cur.pn * tstepB;
    S.a_ready(cur);
    if constexpr (SP2) {
        PG8_STAGE(PG8_SB(0, 0), cB, voffB); PG8_STAGE(PG8_SB(0, 1), cB + hstepB, voffB); PG8_STAGE(PG8_SA(0, 0), cA, voffA); PG8_STAGE(PG8_SA(0, 1), cA + hstepA, voffA);
        if (wr == 1) PG8_BAR;
        PG8_WAIT_V(2); PG8_BAR;
        PG8_STAGE(PG8_SB(1, 0), cB + kstep, voffB); PG8_STAGE(PG8_SA(1, 0), cA + kstep, voffA); PG8_STAGE(PG8_SB(1, 1), cB + hstepB + kstep, voffB);
        PG8_WAIT_V(6); PG8_BAR;
    } else {
        PG8_STAGE(PG8_SB(0, 0), cB, voffB); PG8_STAGE(PG8_SA(0, 0), cA, voffA); PG8_STAGE(PG8_SB(0, 1), cB + hstepB, voffB); PG8_STAGE(PG8_SA(0, 1), cA + hstepA, voffA);
        if (wr == 1) PG8_BAR;
        PG8_WAIT_V(4); PG8_BAR;
        PG8_STAGE(PG8_SB(1, 0), cB + kstep, voffB); PG8_STAGE(PG8_SA(1, 0), cA + kstep, voffA); PG8_STAGE(PG8_SB(1, 1), cB + hstepB + kstep, voffB);
        PG8_WAIT_V(6); PG8_BAR;
    }
    for (;;) {
        const bool has_next = S.next(ui + 1, nxt);
        const char* nA = has_next ? (const char*)g.A + (size_t)nxt.pm * tstepA : cA; const char* nB = has_next ? (const char*)g.Bt + (size_t)nxt.pn * tstepB : cB;
        for (int t = 0; t < nt; t += 2) {
            const bool last = (t == nt - 2);
            const char* a1 = cA + (size_t)(t + 1) * kstep;
            const char* a2 = last ? nA : cA + (size_t)(t + 2) * kstep; const char* b2 = last ? nB : cB + (size_t)(t + 2) * kstep;
            const char* a3 = a2 + kstep; const char* b3 = b2 + kstep;
            if (last && has_next) S.a_ready(nxt);
            if constexpr (SP2) {
            PG8_LDB(B0, 0, 0); PG8_LDB(B1, 0, 1); PG8_SCHED; PG8_LDA(At, 0, 0); PG8_STAGE(PG8_SA(1, 1), a1 + hstepA, voffA);
            PG8_WAIT_V(8); PG8_WAIT_L(0); PG8_BAR; PG8_MMA(0, 0, At, B0); PG8_MMA(0, 1, At, B1); PG8_BAR; PG8_SCHED;
            PG8_LDA(At, 0, 1); PG8_STAGE(PG8_SB(0, 0), b2, voffB); PG8_STAGE(PG8_SB(0, 1), b2 + hstepB, voffB); PG8_STAGE(PG8_SA(0, 0), a2, voffA);
            PG8_WAIT_V(8); PG8_WAIT_L(0); PG8_BAR; PG8_MMA(1, 0, At, B0); PG8_MMA(1, 1, At, B1); PG8_BAR; PG8_SCHED;
            PG8_LDB(B0, 1, 0); PG8_LDB(B1, 1, 1); PG8_SCHED; PG8_LDA(At, 1, 0); PG8_STAGE(PG8_SA(0, 1), a2 + hstepA, voffA);
            PG8_WAIT_V(8); PG8_WAIT_L(0); PG8_BAR; PG8_MMA(0, 0, At, B0); PG8_MMA(0, 1, At, B1); PG8_BAR; PG8_SCHED;
            PG8_LDA(At, 1, 1); PG8_STAGE(PG8_SB(1, 0), b3, voffB); PG8_STAGE(PG8_SB(1, 1), b3 + hstepB, voffB); PG8_STAGE(PG8_SA(1, 0), a3, voffA);
            PG8_WAIT_V(8); PG8_WAIT_L(0); PG8_BAR; PG8_MMA(1, 0, At, B0); PG8_MMA(1, 1, At, B1); PG8_BAR; PG8_SCHED;
            } else {
            PG8_LDB(B0, 0, 0); PG8_SCHED; PG8_LDA(At, 0, 0); PG8_STAGE(PG8_SA(1, 1), a1 + hstepA, voffA);
            PG8_WAIT_L(8); PG8_BAR; PG8_WAIT_L(0); PG8_MMA(0, 0, At, B0); PG8_BAR; PG8_SCHED;
            PG8_LDB(B1, 0, 1); PG8_STAGE(PG8_SB(0, 0), b2, voffB);
            PG8_BAR; PG8_WAIT_L(0); PG8_MMA(0, 1, At, B1); PG8_BAR;
            PG8_LDA(At, 0, 1); PG8_STAGE(PG8_SA(0, 0), a2, voffA);
            PG8_BAR; PG8_WAIT_L(0); PG8_MMA(1, 0, At, B0); PG8_BAR; PG8_SCHED;
            PG8_STAGE(PG8_SB(0, 1), b2 + hstepB, voffB);
            PG8_WAIT_V(6); PG8_BAR; PG8_MMA(1, 1, At, B1); PG8_BAR;
            PG8_LDB(B0, 1, 0); PG8_SCHED; PG8_LDA(At, 1, 0); PG8_STAGE(PG8_SA(0, 1), a2 + hstepA, voffA);
            PG8_WAIT_L(8); PG8_BAR; PG8_WAIT_L(0); PG8_MMA(0, 0, At, B0); PG8_BAR; PG8_SCHED;
            PG8_LDB(B1, 1, 1); PG8_STAGE(PG8_SB(1, 0), b3, voffB);
            PG8_BAR; PG8_WAIT_L(0); PG8_MMA(0, 1, At, B1); PG8_BAR;
            PG8_LDA(At, 1, 1); PG8_STAGE(PG8_SA(1, 0), a3, voffA);
            PG8_BAR; PG8_WAIT_L(0); PG8_MMA(1, 0, At, B0); PG8_BAR; PG8_SCHED;
            PG8_STAGE(PG8_SB(1, 1), b3 + hstepB, voffB);
            PG8_WAIT_V(6); PG8_BAR; PG8_MMA(1, 1, At, B1); PG8_BAR;
            }
        }
        if constexpr (ALIGN_EPI) { if (wr == 0) PG8_BAR; }
        if constexpr (!Epi::AFTER_DRAIN) { E(acc, cur, wr, wc, fr, fq); S.done(cur); }
        if (!has_next) break;
#pragma unroll
        for (int a = 0; a < 2; ++a)
#pragma unroll
            for (int b = 0; b < 2; ++b)
#pragma unroll
                for (int m = 0; m < 4; ++m)
#pragma unroll
                    for (int n = 0; n < 2; ++n) acc[a][b][m][n] = (f32x4){0.f, 0.f, 0.f, 0.f};
        cur = nxt; cA = nA; cB = nB; ++ui;
        if constexpr (ALIGN_EPI) { if (wr == 1) PG8_BAR; }
    }
    PG8_WAIT_V(0);
    if constexpr (!ALIGN_EPI) { if (wr == 0) PG8_BAR; }
    PG8_BAR;
    if constexpr (Epi::AFTER_DRAIN) { E.fused(acc, cur, wr, wc, fr, fq, lds, wid, lane); S.done(cur); }
#undef PG8_SA
#undef PG8_SB
#undef PG8_STAGE
#undef PG8_LDA
#undef PG8_LDB
#undef PG8_MMA
#undef PG8_WAIT_V
#undef PG8_WAIT_L
#undef PG8_BAR
#undef PG8_SCHED
}
}
#define PG8_SP2 true
#define PG8_ALIGN true

#define LAS __attribute__((address_space(3)))
using pg8::bf16_t; using pg8::bf16x8; using pg8::f32x4; using pg8::u32x4;
#define MFMA32(a, b, c) __builtin_amdgcn_mfma_f32_32x32x16_bf16((a), (b), (c), 0, 0, 0)
constexpr size_t MiB = 1u << 20;
constexpr size_t WS_SS = 0;
constexpr size_t WS_BAR = 512 * 1024;
constexpr size_t WS_WIN = 1 * MiB;
constexpr size_t WS_WUQ = 25 * MiB;
constexpr size_t WS_WKV = 26 * MiB + 512 * 1024;
constexpr size_t WS_WOUT = 28 * MiB;
constexpr size_t WS_TAB = 36 * MiB;
constexpr size_t WS_HN = 52 * MiB;
constexpr size_t WS_HT = 180 * MiB;
constexpr size_t WS_XB = 244 * MiB;
constexpr size_t WS_Q = 244 * MiB, WS_KR = 500 * MiB;
constexpr size_t WS_ST = 308 * MiB;
constexpr size_t WS_WGU = 308 * MiB, WS_WD = 352 * MiB;
constexpr size_t WS_KN = 436 * MiB;
constexpr size_t WS_VT = 468 * MiB;
constexpr size_t WS_ACT = 52 * MiB;
constexpr size_t WS_END = 502 * MiB;
constexpr int LDS_BYTES = 131072 + 1024;
constexpr int NPH = 17;

__device__ __forceinline__ float wave_sum(float v, int lane) {
#pragma unroll
    for (int o = 1; o < 64; o <<= 1) v += shx(v, o, lane);
    return v;
}
#define XB_TMO      128
#define XB_XCNT(j)  (256  + 64 * (j))
#define XB_XSUB(j)  (1280 + 64 * (j))
#define XB_XGEN(j)  (2304 + 64 * (j))
#define XB_TOP      3328
#define XB_TOPGEN   3392
#define XCD_BAR_WORDS 3456
#define XB_SPIN_CAP (1u << 18)

__device__ __forceinline__ unsigned xb_ld(unsigned* p)              { return __hip_atomic_load(p, __ATOMIC_RELAXED, __HIP_MEMORY_SCOPE_AGENT); }
__device__ __forceinline__ unsigned xb_add(unsigned* p, unsigned v) { return __hip_atomic_fetch_add(p, v, __ATOMIC_RELAXED, __HIP_MEMORY_SCOPE_AGENT); }
__device__ __forceinline__ unsigned xb_xcc_id() { return (unsigned)__builtin_amdgcn_s_getreg((3 << 11) | 20) & 0xFu; }
#define XB_SPIN(cond, bar) do { unsigned _sp = 0; while (cond) { __builtin_amdgcn_s_sleep(1); \
    if ((++_sp & 255u) == 0u) { if (xb_ld(&(bar)[XB_TMO])) break; if (_sp > XB_SPIN_CAP) { atomicAdd(&(bar)[XB_TMO], 1u); break; } } } } while (0)

struct XcdBarrier {
    unsigned* bar; unsigned x;
    volatile LAS unsigned* st;
};

__device__ __forceinline__ XcdBarrier xcd_barrier_post(unsigned* bar, volatile LAS unsigned* st) {
    XcdBarrier b; b.bar = bar; b.x = xb_xcc_id(); b.st = st;
    if (threadIdx.x == 0) (void)xb_add(&bar[XB_XCNT(b.x)], 1u);
    return b;
}
__device__ __forceinline__ void xcd_barrier_complete(unsigned* bar, unsigned x, unsigned& nloc, unsigned& nx) {
    const unsigned G = gridDim.x * gridDim.y * gridDim.z;
    unsigned sum, cnt, mine, sp = 0u;
    for (;;) {
        sum = 0u; cnt = 0u; mine = 0u;
#pragma unroll
        for (unsigned j = 0; j < 16; ++j) { const unsigned c = xb_ld(&bar[XB_XCNT(j)]); sum += c; cnt += (c > 0u) ? 1u : 0u; mine = (j == x) ? c : mine; }
        if (sum == G) break;
        __builtin_amdgcn_s_sleep(1);
        if ((++sp & 255u) == 0u) { if (xb_ld(&bar[XB_TMO])) break; if (sp > XB_SPIN_CAP) { atomicAdd(&bar[XB_TMO], 1u); break; } }
    }
    nloc = mine > 0u ? mine : 1u; nx = cnt > 0u ? cnt : 1u;
}

__device__ __forceinline__ void xcd_barrier(const XcdBarrier& b) {
    asm volatile("s_waitcnt vmcnt(0)" ::: "memory");
    __syncthreads();
    if (threadIdx.x == 0) {
        unsigned* bar = b.bar;
        __builtin_amdgcn_s_waitcnt(0);
        unsigned nloc = b.st[0], nx = b.st[1];
        if (nloc == 0u) { xcd_barrier_complete(bar, b.x, nloc, nx); b.st[0] = nloc; b.st[1] = nx; }
        const unsigned old = xb_add(&bar[XB_XSUB(b.x)], 1u);
        const unsigned gen = old / nloc;
        if (old + 1u == (gen + 1u) * nloc) {
            __builtin_amdgcn_fence(__ATOMIC_RELEASE, "agent");
            asm volatile("s_waitcnt vmcnt(0)" ::: "memory");
            const unsigned og = xb_add(&bar[XB_TOP], 1u);
            const unsigned tg = og / nx;
            if (og + 1u == (tg + 1u) * nx) xb_add(&bar[XB_TOPGEN], 1u);
            else XB_SPIN(xb_ld(&bar[XB_TOPGEN]) == tg, bar);
            __builtin_amdgcn_fence(__ATOMIC_ACQUIRE, "agent");
            xb_add(&bar[XB_XGEN(b.x)], 1u);
            asm volatile("s_waitcnt vmcnt(0)" ::: "memory");
        } else {
            XB_SPIN(xb_ld(&bar[XB_XGEN(b.x)]) == gen, bar);
            __builtin_amdgcn_fence(__ATOMIC_ACQUIRE, "agent");
            asm volatile("s_waitcnt vmcnt(0)" ::: "memory");
        }
    }
    __syncthreads();
}

template <int MODE> __device__ __forceinline__ void rowmap(int n, int& r1, int& r2) {
    r2 = -1;
    if (MODE == 0) {
        if (n < 800) r1 = n;
        else if (n < 832) r1 = n + 96;
        else if (n < 1856) r1 = 2048 + (n - 832);
        else if (n < 2880) { r1 = 3072 + (n - 1856); r2 = 4096 + (n - 1856); }
        else if (n < 3904) r1 = 5120 + (n - 2880);
        else r1 = 1024 + (n - 3904);
    } else if (MODE == 1) {
        const int h = n / 192, d = n % 192;
        if (d < 128) r1 = (h >> 1) * 256 + (h & 1) * 128 + d;
        else { const int i = d - 128; r1 = 1024 + (h >> 2) * 256 + (i >> 5) * 128 + (h & 3) * 32 + (i & 31); }
    } else if (MODE == 2) {
        const int h = n >> 8, d = n & 255;
        r1 = d < 128 ? h * 128 + d : 1024 + h * 128 + (d - 128);
    } else if (MODE == 3) r1 = n;
    else if (MODE == 4) r1 = 8 * (n >> 2) + (n & 3);
    else r1 = 8 * (n >> 2) + 4 + (n & 3);
}
template <int MODE> __device__ __forceinline__ void cvt_item(const float* __restrict__ W, int K, int N, const float* __restrict__ ksc, bf16_t* WT, LAS float* scr, int item, int lane) {
    const int nblk = N / 32, kb = item / nblk, nb = item % nblk, k0 = 64 * kb, n0 = 32 * nb;
#pragma unroll 8
    for (int i = 0; i < 32; ++i) { const int kk = 2 * i + (lane >> 5); float v = W[(size_t)(k0 + kk) * N + n0 + (lane & 31)]; if (ksc) v *= ksc[k0 + kk]; scr[kk * 33 + (lane & 31)] = v; }
    asm volatile("s_waitcnt lgkmcnt(0)" ::: "memory");
    const int c = lane & 7;
#pragma unroll
    for (int j = 0; j < 4; ++j) {
        const int n = (lane >> 3) + 8 * j; const LAS float* s = scr + (8 * c) * 33 + n;
        u32x4 o; o.x = pk2(s[0 * 33], s[1 * 33]); o.y = pk2(s[2 * 33], s[3 * 33]); o.z = pk2(s[4 * 33], s[5 * 33]); o.w = pk2(s[6 * 33], s[7 * 33]);
        int r1, r2; rowmap<MODE>(n0 + n, r1, r2);
        *(u32x4*)(WT + (size_t)r1 * K + k0 + 8 * c) = o;
        if (MODE == 0) { if (r2 >= 0) *(u32x4*)(WT + (size_t)r2 * K + k0 + 8 * c) = o; }
    }
    asm volatile("s_waitcnt lgkmcnt(0)" ::: "memory");
}
__device__ __forceinline__ void ln_row(const float* src, float* dstf, bf16_t* dstb, const float* __restrict__ g, const float* __restrict__ b, int lane) {
    f32x4 v[8]; float s = 0.f;
#pragma unroll
    for (int j = 0; j < 8; ++j) { v[j] = ((const f32x4*)src)[lane + 64 * j]; s += (v[j][0] + v[j][1]) + (v[j][2] + v[j][3]); }
    const float mean = wave_sum(s, lane) * (1.0f / 2048.0f); float s2 = 0.f;
#pragma unroll
    for (int j = 0; j < 8; ++j) { v[j] = v[j] - mean; s2 += pg8::dot4(v[j]); }
    const float rstd = rsqrtf(wave_sum(s2, lane) * (1.0f / 2048.0f) + 1e-5f);
#pragma unroll
    for (int j = 0; j < 8; ++j) {
        const f32x4 gg = ((const f32x4*)g)[lane + 64 * j], bb = ((const f32x4*)b)[lane + 64 * j];
        const f32x4 o = v[j] * rstd * gg + bb;
        ((f32x4*)dstf)[lane + 64 * j] = o;
        u32x2 w; w.x = pk2(o[0], o[1]); w.y = pk2(o[2], o[3]);
        ((u32x2*)dstb)[lane + 64 * j] = w;
    }
}
__device__ __forceinline__ int sig32(int r) { return (r & 0x13) | ((r & 4) << 1) | ((r & 8) >> 1); }
__device__ __forceinline__ bf16x8 pack_half(const f32x16& x, int s) {
    u32x4 p; p.x = pk2(x[8 * s + 0], x[8 * s + 1]); p.y = pk2(x[8 * s + 2], x[8 * s + 3]); p.z = pk2(x[8 * s + 4], x[8 * s + 5]); p.w = pk2(x[8 * s + 6], x[8 * s + 7]);
    return __builtin_bit_cast(bf16x8, p);
}
__device__ __forceinline__ f32x16 zero16() { f32x16 z;
#pragma unroll
    for (int i = 0; i < 16; ++i) z[i] = 0.f; return z; }

__device__ __forceinline__ bf16x8 ldf(const bf16_t* ub, unsigned off) { return *(const bf16x8*)((const char*)ub + off); }
__device__ __forceinline__ u32x2 ld8(const bf16_t* ub, unsigned off) { return *(const u32x2*)((const char*)ub + off); }
__device__ __forceinline__ void st8(bf16_t* ub, unsigned off, u32x2 v) { *(u32x2*)((char*)ub + off) = v; }

__device__ __forceinline__ void scan_wave(const bf16_t* __restrict__ hT, bf16_t* __restrict__ ST, int wt, int lane) {
    asm volatile("" : "+v"(lane));
    const int r32 = lane & 31, hi = lane >> 5;
    const int bh = wt >> 6, it = (wt >> 3) & 7, jt = wt & 7, h = bh & 3, b = bh >> 2;
    const bf16_t* kd = hT + (size_t)(h * 256 + 32 * it) * TOK + (size_t)b * SEQ;
    const bf16_t* vv = hT + (size_t)(1024 + h * 256 + 32 * jt) * TOK + (size_t)b * SEQ;
    const unsigned lo = (unsigned)(r32 * TOK + 8 * hi) * 2u;
    bf16_t* so = ST + ((size_t)(bh * 64) << 16) + (32 * jt) * 256 + 32 * it;
    const unsigned so_l = (unsigned)(r32 * 256 + 4 * hi) * 2u;
    const float g64 = __builtin_amdgcn_exp2f(64.0f * lg2gamma(h));
    f32x16 st = zero16();
#pragma unroll 2
    for (int c = 0; c < 64; ++c) {
#pragma unroll
        for (int a = 0; a < 4; ++a) { u32x2 w; w.x = pk2(st[4 * a], st[4 * a + 1]); w.y = pk2(st[4 * a + 2], st[4 * a + 3]); st8(so + ((size_t)c << 16) + 8 * a, so_l, w); }
        if (c < 63) {
            st = st * g64;
#pragma unroll
            for (int ks = 0; ks < 4; ++ks) {
                const bf16x8 af = ldf(kd + 64 * c + 16 * ks, lo), bfr = ldf(vv + 64 * c + 16 * ks, lo);
                st = MFMA32(af, bfr, st);
            }
        }
    }
}
__device__ __forceinline__ void retc_half(f32x16 (&acc)[4], int hf, bool has_state, const bf16_t* su, unsigned s_l, const bf16_t* hNu, unsigned q_l, float qd,
                                          const bf16_t* vu, unsigned v_l, const bf16x8 p0, const bf16x8 p1, const bf16x8 p2, const bf16x8 p3) {
#pragma unroll
    for (int e = 0; e < 4; ++e) acc[e] = zero16();
    if (has_state) {
#pragma unroll 2
        for (int ks = 0; ks < 16; ++ks) {
            const bf16x8 qf = ldf(hNu + 2048 + 16 * ks, q_l);
#pragma unroll
            for (int e = 0; e < 4; ++e) { const bf16x8 af = ldf(su + (4 * hf + e) * 8192 + 16 * ks, s_l); acc[e] = MFMA32(af, qf, acc[e]); }
            asm volatile("" ::: "memory");
        }
#pragma unroll
        for (int e = 0; e < 4; ++e) acc[e] = acc[e] * qd;
    }
#pragma unroll
    for (int e = 0; e < 4; ++e) {
        const bf16_t* ve = vu + (size_t)(4 * hf + e) * 32 * TOK;
        const bf16x8 v0 = ldf(ve, v_l), v1 = ldf(ve + 16, v_l), v2 = ldf(ve + 32, v_l), v3 = ldf(ve + 48, v_l);
        acc[e] = MFMA32(v0, p0, acc[e]); acc[e] = MFMA32(v1, p1, acc[e]); acc[e] = MFMA32(v2, p2, acc[e]); acc[e] = MFMA32(v3, p3, acc[e]);
        if (e & 1) asm volatile("" ::: "memory");
    }
}
__device__ __forceinline__ void retc_wave(bf16_t* hN, const bf16_t* __restrict__ hT, const bf16_t* __restrict__ ST, const float* __restrict__ gng, const float* __restrict__ gnb, int task, int lane) {
    asm volatile("" : "+v"(lane));
    const int r32 = lane & 31, hi = lane >> 5;
    const int half = task & 1, c = (task >> 1) & 63, bh = task >> 7, h = bh & 3, b = bh >> 2;
    const size_t tok0 = (size_t)b * SEQ + 64 * c;
    const int nl = 32 * half + r32;
    const float lg2 = lg2gamma(h);
    bf16_t* hNu = hN + tok0 * 4096 + h * 256;
    const unsigned q_l = (unsigned)(nl * 4096 + 8 * hi) * 2u;
    const unsigned k_l = (unsigned)(sig32(r32) * 4096 + 8 * hi) * 2u;
    const unsigned g_l = (unsigned)(nl * 4096 + 4 * hi) * 2u;
    bf16x8 p0, p1, p2, p3;
    {
        f32x16 s0 = zero16(), s1 = zero16();
#pragma unroll 2
        for (int ks = 0; ks < 16; ++ks) {
            const bf16x8 qf = ldf(hNu + 2048 + 16 * ks, q_l);
            const bf16x8 k0 = ldf(hNu + 3072 + 16 * ks, k_l), k1 = ldf(hNu + 3072 + 32 * 4096 + 16 * ks, k_l);
            s0 = MFMA32(k0, qf, s0); s1 = MFMA32(k1, qf, s1);
            if ((ks & 1) == 1) asm volatile("" ::: "memory");
        }
#pragma unroll
        for (int i = 0; i < 16; ++i) {
            const int m0 = 16 * (i >> 3) + 8 * hi + (i & 7);
            s0[i] *= __builtin_amdgcn_exp2f(lg2 * fabsf((float)(nl - m0)));
            s1[i] *= __builtin_amdgcn_exp2f(lg2 * fabsf((float)(nl - m0 - 32)));
        }
        p0 = pack_half(s0, 0); p1 = pack_half(s0, 1); p2 = pack_half(s1, 0); p3 = pack_half(s1, 1);
    }
    const bf16_t* su = ST + ((size_t)(bh * 64 + c) << 16);
    const unsigned s_l = (unsigned)(r32 * 256 + 8 * hi) * 2u;
    const float qd = __builtin_amdgcn_exp2f(lg2 * (float)(nl + 1));
    const bf16_t* vu = hT + (size_t)(1024 + h * 256) * TOK + tok0;
    const unsigned v_l = (unsigned)(r32 * TOK + 8 * hi) * 2u;
    float s = 0.f, q = 0.f;
    unsigned pa[32];
    {
        f32x16 acc[4];
        retc_half(acc, 0, c > 0, su, s_l, hNu, q_l, qd, vu, v_l, p0, p1, p2, p3);
#pragma unroll
        for (int e = 0; e < 4; ++e)
#pragma unroll
            for (int i = 0; i < 16; i += 2) { const float x0 = acc[e][i], x1 = acc[e][i + 1]; s += x0 + x1; q += x0 * x0 + x1 * x1; pa[8 * e + (i >> 1)] = pk2(x0, x1); }
    }
    f32x16 acc[4];
    retc_half(acc, 1, c > 0, su, s_l, hNu, q_l, qd, vu, v_l, p0, p1, p2, p3);
#pragma unroll
    for (int e = 0; e < 4; ++e)
#pragma unroll
        for (int i = 0; i < 16; ++i) { s += acc[e][i]; q += acc[e][i] * acc[e][i]; }
    s += shx(s, 32, lane); q += shx(q, 32, lane);
    const float mu = s * (1.0f / 256.0f);
    const float rstd = rsqrtf(fmaxf(q * (1.0f / 256.0f) - mu * mu, 0.f) + 1e-5f);
    const float* gg = gng + h * 256 + 4 * hi; const float* gb = gnb + h * 256 + 4 * hi;
#pragma unroll
    for (int e = 0; e < 8; ++e)
#pragma unroll
        for (int a = 0; a < 4; ++a) {
            const int e0 = 32 * e + 8 * a;
            const f32x4 g4 = *(const f32x4*)(gg + e0), b4 = *(const f32x4*)(gb + e0);
            const u32x2 rw = ld8(hNu + 1024 + e0, g_l);
            const float r0 = bf_lo(rw.x), r1 = bf_hi(rw.x), r2 = bf_lo(rw.y), r3 = bf_hi(rw.y);
            float x[4];
            if (e < 4) { const unsigned w0 = pa[8 * e + 2 * a], w1 = pa[8 * e + 2 * a + 1]; x[0] = bf_lo(w0); x[1] = bf_hi(w0); x[2] = bf_lo(w1); x[3] = bf_hi(w1); }
            else { x[0] = acc[e & 3][4 * a]; x[1] = acc[e & 3][4 * a + 1]; x[2] = acc[e & 3][4 * a + 2]; x[3] = acc[e & 3][4 * a + 3]; }
            float y[4];
#pragma unroll
            for (int j = 0; j < 4; ++j) y[j] = (x[j] - mu) * rstd * g4[j] + b4[j];
            y[0] *= r0 * __builtin_amdgcn_rcpf(1.0f + __builtin_amdgcn_exp2f(-1.4426950408889634f * r0));
            y[1] *= r1 * __builtin_amdgcn_rcpf(1.0f + __builtin_amdgcn_exp2f(-1.4426950408889634f * r1));
            y[2] *= r2 * __builtin_amdgcn_rcpf(1.0f + __builtin_amdgcn_exp2f(-1.4426950408889634f * r2));
            y[3] *= r3 * __builtin_amdgcn_rcpf(1.0f + __builtin_amdgcn_exp2f(-1.4426950408889634f * r3));
            u32x2 w; w.x = pk2(y[0], y[1]); w.y = pk2(y[2], y[3]);
            st8(hNu + 1024 + e0, g_l, w);
            if (a & 1) asm volatile("" ::: "memory");
        }
}
constexpr int ATT_KBYTES = 64 * 384, ATT_VBYTES = 128 * 128, ATT_BUF = ATT_KBYTES + ATT_VBYTES;
__device__ __forceinline__ void attn_unit(LAS unsigned char* lds, const bf16_t* __restrict__ Q, const bf16_t* __restrict__ Kn, const bf16_t* __restrict__ KR, const bf16_t* __restrict__ VT, bf16_t* O, int b, int h, int qb8) {
    int tid = threadIdx.x; asm volatile("" : "+v"(tid));
    const int lane = tid & 63, wave = __builtin_amdgcn_readfirstlane(tid >> 6), r32 = lane & 31, hi = lane >> 5;
    const int qg = 8 * qb8 + wave;
    const size_t n0 = (size_t)b * SEQ + 32 * qg;
    bf16x8 qf[12];
    { const bf16_t* qu = Q + n0 * 1536 + h * 192; const unsigned q_l = (unsigned)(r32 * 1536 + 8 * hi) * 2u;
#pragma unroll
      for (int ks = 0; ks < 12; ++ks) qf[ks] = ldf(qu + 16 * ks, q_l); }
    const int kr0 = tid >> 4, kc0 = tid & 15, rr = tid >> 3, rc = tid & 7;
    const unsigned kst = (unsigned)(kr0 * 384 + (((kc0 & 8) | ((kc0 ^ (kr0 >> 1)) & 7)) << 4));
    const unsigned rst = (unsigned)(rr * 384 + ((16 | ((rc ^ (rr >> 1)) & 7)) << 4));
    const unsigned vst = (unsigned)(ATT_KBYTES + rr * 128 + (((rc ^ (rr >> 1)) & 7) << 4));
    const unsigned gk = (unsigned)(kr0 * 1024 + kc0 * 8) * 2u, gr = (unsigned)(rr * 64 + rc * 8) * 2u, gv = (unsigned)(rr * TOK + rc * 8) * 2u;
    const bf16_t* ku = Kn + (size_t)b * SEQ * 1024 + h * 128;
    const bf16_t* ru = KR + (size_t)b * SEQ * 64;
    const bf16_t* vu = VT + (size_t)h * 128 * TOK + (size_t)b * SEQ;
    const int sg = sig32(r32), sk = (sg >> 1) & 7, sv = (r32 >> 1) & 7;
    unsigned koff[4], voff[4];
#pragma unroll
    for (int k2 = 0; k2 < 4; ++k2) {
        koff[k2] = (unsigned)(sg * 384 + ((((2 * k2) ^ (sk & 6)) | (hi ^ (sk & 1))) << 4));
        voff[k2] = (unsigned)(ATT_KBYTES + r32 * 128 + ((((2 * k2) ^ (sv & 6)) | (hi ^ (sv & 1))) << 4));
    }
    f32x16 o[4];
#pragma unroll
    for (int d = 0; d < 4; ++d) o[d] = zero16();
    float mrun = -1e30f, l = 0.f;
    const int nt_blk = 4 * qb8 + 4, nt_w = (qg >> 1) + 1;
    bf16x8 g0, g1, g2, g3, g4;
#define ATT_GLOAD(kt) do { const bf16_t* k0_ = ku + (size_t)(kt) * 64 * 1024; g0 = ldf(k0_, gk); g1 = ldf(k0_ + 32 * 1024, gk); g2 = ldf(ru + (size_t)(kt) * 64 * 64, gr); \
        const bf16_t* v0_ = vu + (kt) * 64; g3 = ldf(v0_, gv); g4 = ldf(v0_ + (size_t)64 * TOK, gv); } while (0)
#define ATT_LWRITE(bufo) do { LAS unsigned char* p_ = lds + (bufo); *(LAS bf16x8*)(p_ + kst) = g0; *(LAS bf16x8*)(p_ + kst + 32 * 384) = g1; *(LAS bf16x8*)(p_ + rst) = g2; \
        *(LAS bf16x8*)(p_ + vst) = g3; *(LAS bf16x8*)(p_ + vst + 64 * 128) = g4; } while (0)
    ATT_GLOAD(0);
    ATT_LWRITE(0);
    __syncthreads();
    for (int kt = 0; kt < nt_blk; ++kt) {
        const bool more = kt + 1 < nt_blk;
        if (more) ATT_GLOAD(kt + 1);
        if (kt < nt_w) {
            const LAS unsigned char* bp = lds + (kt & 1) * ATT_BUF;
            f32x16 s0 = zero16(), s1 = zero16();
#pragma unroll
            for (int ks = 0; ks < 12; ++ks) {
                const bf16x8 a0 = *(const LAS bf16x8*)(bp + koff[ks & 3] + (ks >> 2) * 128), a1 = *(const LAS bf16x8*)(bp + koff[ks & 3] + (ks >> 2) * 128 + 32 * 384);
                s0 = MFMA32(a0, qf[ks], s0); s1 = MFMA32(a1, qf[ks], s1);
            }
            float mx = fmaxf(s0[0], s1[0]);
#pragma unroll
            for (int i = 1; i < 16; ++i) mx = fmaxf(mx, fmaxf(s0[i], s1[i]));
            mx = fmaxf(mx, shx(mx, 32, lane));
            const float mn = fmaxf(mrun, mx), al = __builtin_amdgcn_exp2f(mrun - mn); mrun = mn;
            float ps = 0.f;
#pragma unroll
            for (int i = 0; i < 16; ++i) { s0[i] = __builtin_amdgcn_exp2f(s0[i] - mn); s1[i] = __builtin_amdgcn_exp2f(s1[i] - mn); ps += s0[i] + s1[i]; }
            l = l * al + ps;
#pragma unroll
            for (int d = 0; d < 4; ++d) o[d] = o[d] * al;
            const bf16x8 p0 = pack_half(s0, 0), p1 = pack_half(s0, 1), p2 = pack_half(s1, 0), p3 = pack_half(s1, 1);
#pragma unroll
            for (int d = 0; d < 4; ++d) {
                const bf16x8 f0 = *(const LAS bf16x8*)(bp + voff[0] + d * 4096), f1 = *(const LAS bf16x8*)(bp + voff[1] + d * 4096),
                             f2 = *(const LAS bf16x8*)(bp + voff[2] + d * 4096), f3 = *(const LAS bf16x8*)(bp + voff[3] + d * 4096);
                o[d] = MFMA32(f0, p0, o[d]); o[d] = MFMA32(f1, p1, o[d]); o[d] = MFMA32(f2, p2, o[d]); o[d] = MFMA32(f3, p3, o[d]);
            }
        }
        if (more) ATT_LWRITE(((kt + 1) & 1) * ATT_BUF);
        __syncthreads();
    }
#undef ATT_GLOAD
#undef ATT_LWRITE
    l += shx(l, 32, lane);
    const float inv = 1.0f / l;
    bf16_t* ou = O + n0 * 4096 + h * 128; const unsigned o_l = (unsigned)(r32 * 4096 + 4 * hi) * 2u;
#pragma unroll
    for (int d = 0; d < 4; ++d)
#pragma unroll
        for (int a = 0; a < 4; ++a) {
            u32x2 w; w.x = pk2(o[d][4 * a] * inv, o[d][4 * a + 1] * inv); w.y = pk2(o[d][4 * a + 2] * inv, o[d][4 * a + 3] * inv);
            st8(ou + 32 * d + 8 * a, o_l, w);
        }
}
typedef __attribute__((address_space(4))) const char* kptr_t;
template <class T> __device__ __forceinline__ T* karg(kptr_t kp, int off) { typedef __attribute__((address_space(1))) T* Gp; return (T*)(*(const __attribute__((address_space(4))) Gp*)(kp + off)); }
struct Args { const float* in[19]; float* out; unsigned char* ws; int ph_lo, ph_hi; };

__global__ void __launch_bounds__(512, 2) mk_fwd(Args a) {
    extern __shared__ __attribute__((aligned(16))) unsigned char lds_raw[];
    LAS unsigned char* lds = (LAS unsigned char*)lds_raw;
    LAS unsigned char* lds_raw_las = lds;
    cg::this_grid().sync();
    if (threadIdx.x < 4) ((volatile LAS unsigned*)(lds_raw_las + 131072))[threadIdx.x] = 0u;
    __syncthreads();
    XcdBarrier bar = xcd_barrier_post((unsigned*)(a.ws + WS_BAR), (volatile LAS unsigned*)(lds_raw_las + 131072));
        const int G = gridDim.x, bx0 = blockIdx.x;
    const int NGW = G * 8;
    const int NTH = G * 512;
    const kptr_t kp0 = (kptr_t)__builtin_amdgcn_kernarg_segment_ptr();
#define KARG(T, off) (karg<T>(kp, (off)))
#define IN(i) KARG(const float, 8 * (i))
#define x_in IN(0)
#define positions ((const int*)IN(1))
#define xres KARG(float, 152)
#define ssb ((float*)(ws + WS_SS))
#define Win_t ((bf16_t*)(ws + WS_WIN))
#define Wuq_t ((bf16_t*)(ws + WS_WUQ))
#define Wkv_t ((bf16_t*)(ws + WS_WKV))
#define Wout_t ((bf16_t*)(ws + WS_WOUT))
#define Wgu_t ((bf16_t*)(ws + WS_WGU))
#define Wd_t ((bf16_t*)(ws + WS_WD))
#define cosT ((float*)(ws + WS_TAB))
#define sinT ((float*)(ws + WS_TAB) + (size_t)TOK * 128)
#define hN ((bf16_t*)(ws + WS_HN))
#define hT ((bf16_t*)(ws + WS_HT))
#define xb ((bf16_t*)(ws + WS_XB))
#define Qb ((bf16_t*)(ws + WS_Q))
#define KR ((bf16_t*)(ws + WS_KR))
#define ST ((bf16_t*)(ws + WS_ST))
#define Kn ((bf16_t*)(ws + WS_KN))
#define VT ((bf16_t*)(ws + WS_VT))
#define act ((bf16_t*)(ws + WS_ACT))
    int ph = 0;
#define PH_BEGIN if (a.ph_lo <= ph && ph < a.ph_hi) { kptr_t kp = kp0; asm volatile("" : "+s"(kp)); unsigned char* const ws = KARG(unsigned char, 160); int bx = bx0; asm volatile("" : "+s"(bx));
#define IDS int tid_ = threadIdx.x; asm volatile("" : "+v"(tid_)); const int lane = tid_ & 63; const int wave = __builtin_amdgcn_readfirstlane(tid_ >> 6); const int gw = wave * G + bx; LAS float* scr = (LAS float*)(lds + wave * 16384); const int gtid = bx * 512 + wave * 64 + lane; (void)scr; (void)gtid; (void)gw;
#define PH_END   if (ph + 1 < a.ph_hi) { XcdBarrier b2 = bar; asm volatile("" : "+s"(b2.bar)); xcd_barrier(b2); } } ++ph;

#define CVT_ATTN(l) do { \
        const float* w_in_l = IN(4) + (size_t)(l) * 2048 * 4928; const float* w_uq_l = IN(7) + (size_t)(l) * 512 * 1536; \
        const float* w_ukv_l = IN(8) + (size_t)(l) * 256 * 2048; const float* w_out_l = IN(11) + (size_t)(l) * 2048 * 2048; \
        const float* qng = IN(5) + (l) * 512; const float* kvng = IN(6) + (l) * 256; \
        for (int it = gw; it < 7616; it += NGW) { int r = it; \
            if (r < 4928) { cvt_item<0>(w_in_l, 2048, 4928, nullptr, Win_t, scr, r, lane); continue; } r -= 4928; \
            if (r < 384) { cvt_item<1>(w_uq_l, 512, 1536, qng, Wuq_t, scr, r, lane); continue; } r -= 384; \
            if (r < 256) { cvt_item<2>(w_ukv_l, 256, 2048, kvng, Wkv_t, scr, r, lane); continue; } r -= 256; \
            cvt_item<3>(w_out_l, 2048, 2048, nullptr, Wout_t, scr, r, lane); } \
        for (int i = gtid; i < 192 * 256; i += NTH) { const int rr = i >> 8, cc = i & 255; const int row = rr < 96 ? 800 + rr : 928 + (rr - 96); \
            unsigned z = 0u; asm volatile("" : "+v"(z)); *(u32x4*)(Win_t + (size_t)row * 2048 + cc * 8) = (u32x4){z, z, z, z}; } \
    } while (0)
#define CVT_FFN(l) do { \
        const float* w_g = IN(14) + (size_t)(l) * 2048 * 5632; const float* w_u = IN(15) + (size_t)(l) * 2048 * 5632; const float* w_d = IN(16) + (size_t)(l) * 5632 * 2048; \
        for (int it = gw; it < 3 * 5632; it += NGW) { int r = it; \
            if (r < 5632) { cvt_item<4>(w_g, 2048, 5632, nullptr, Wgu_t, scr, r, lane); continue; } r -= 5632; \
            if (r < 5632) { cvt_item<5>(w_u, 2048, 5632, nullptr, Wgu_t, scr, r, lane); continue; } r -= 5632; \
            cvt_item<3>(w_d, 5632, 2048, nullptr, Wd_t, scr, r, lane); } \
    } while (0)

    PH_BEGIN
        IDS
        for (int idx = gtid; idx < TOK * 128; idx += NTH) {
            const int t = idx >> 7, j = idx & 127;
            const float invf = __builtin_amdgcn_exp2f(-(float)j * (13.287712379549449f / 128.0f));
            const double rev = (double)positions[t] * (double)invf * 0.15915494309189535;
            const float fr = (float)(rev - __builtin_rint(rev));
            cosT[idx] = __builtin_amdgcn_cosf(fr); sinT[idx] = __builtin_amdgcn_sinf(fr);
        }
        for (int i = gtid; i < 4 * TOK; i += NTH) ssb[i] = 0.f;
#ifndef DIS_CVT
        CVT_ATTN(0);
#endif
#ifndef DIS_LN
        for (int m = gw; m < TOK; m += NGW) ln_row(x_in + (size_t)m * DM, xres + (size_t)m * DM, xb + (size_t)m * DM, IN(2), IN(3), lane);
#endif
    PH_END

    for (int l = 0; l < 2; ++l) {

        PH_BEGIN
            float* ssq = ssb + (size_t)l * 2 * TOK; float* sskv = ssq + TOK;
#ifndef DIS_G1
            { pg8::Gemm g{xb, Win_t, TOK, 4096, 2048, 2048, 2048}; pg8::StaticOrder S; S.init(TOK, 4096, G, bx);
              pg8::EpiIn E{hN, KR, ssq, sskv, cosT, sinT};
              pg8::gemm_phase<pg8::EpiIn, pg8::StaticOrder, PG8_ALIGN, PG8_SP2>(lds, g, S, E); }
#endif
#ifndef DIS_G2
            { pg8::Gemm g{Win_t + (size_t)4096 * 2048, xb, 2048, TOK, 2048, 2048, 2048}; pg8::StaticOrder S; S.init(2048, TOK, G, bx);
              pg8::EpiInT E{hT, cosT, sinT};
              pg8::gemm_phase<pg8::EpiInT, pg8::StaticOrder, PG8_ALIGN, PG8_SP2>(lds, g, S, E); }
#endif
        PH_END
        PH_BEGIN
            float* ssq = ssb + (size_t)l * 2 * TOK; float* sskv = ssq + TOK;
#ifndef DIS_G3
            { pg8::Gemm g{hN, Wuq_t, TOK, 1536, 512, 4096, 512}; pg8::StaticOrder S; S.init(TOK, 1536, G, bx);
              pg8::EpiQ E{Qb, ssq, cosT, sinT};
              pg8::gemm_phase<pg8::EpiQ, pg8::StaticOrder, PG8_ALIGN, PG8_SP2>(lds, g, S, E); }
#endif
#ifndef DIS_G4
            { pg8::Gemm g{hN + 512, Wkv_t, TOK, 1024, 256, 4096, 256}; pg8::StaticOrder S; S.init(TOK, 1024, G, bx);
              pg8::EpiK E{Kn, sskv};
              pg8::gemm_phase<pg8::EpiK, pg8::StaticOrder, PG8_ALIGN, PG8_SP2>(lds, g, S, E); }
#endif
#ifndef DIS_G5
            { pg8::Gemm g{Wkv_t + (size_t)1024 * 256, hN + 512, 1024, TOK, 256, 256, 4096}; pg8::StaticOrder S; S.init(1024, TOK, G, bx);
              pg8::EpiVT E{VT, sskv};
              pg8::gemm_phase<pg8::EpiVT, pg8::StaticOrder, PG8_ALIGN, PG8_SP2>(lds, g, S, E); }
#endif
#ifndef DIS_SCAN
            { IDS
            for (int wt = gw; wt < 1024; wt += NGW) scan_wave(hT, ST, wt, lane); }
#endif
        PH_END
        PH_BEGIN
            IDS
            for (int bt = bx; bt < 512; bt += G) {
                const int b2 = bt & 255, xcd = b2 & 7, y = b2 >> 3, bh = xcd * 4 + (y >> 3), q8 = y & 7;
                const int qb8 = bt < 256 ? q8 : 15 - q8;
#ifndef DIS_ATTN
                attn_unit(lds, Qb, Kn, KR, VT, hN, bh >> 3, bh & 7, qb8);
#endif
            }
#ifndef DIS_RETC
            for (int task = bx * 8 + wave; task < 2048; task += NGW) retc_wave(hN, hT, ST, IN(9) + l * 1024, IN(10) + l * 1024, task, lane);
#endif
        PH_END
        PH_BEGIN
#ifndef DIS_G6
            { pg8::Gemm g{hN, Wout_t, TOK, 2048, 2048, 4096, 2048}; pg8::StaticOrder S; S.init(TOK, 2048, G, bx);
              pg8::EpiRes E{xres};
              pg8::gemm_phase<pg8::EpiRes, pg8::StaticOrder, PG8_ALIGN, PG8_SP2>(lds, g, S, E); }
#endif
        PH_END
        PH_BEGIN
            IDS
#ifndef DIS_LN
            for (int m = gw; m < TOK; m += NGW) ln_row(xres + (size_t)m * DM, xres + (size_t)m * DM, xb + (size_t)m * DM, IN(12) + l * DM, IN(13) + l * DM, lane);
#endif
#ifndef DIS_CVT
            CVT_FFN(l);
#endif
        PH_END
        PH_BEGIN
#ifndef DIS_G7
            { pg8::Gemm g{xb, Wgu_t, TOK, 2 * DFF, 2048, 2048, 2048}; pg8::StaticOrder S; S.init(TOK, 2 * DFF, G, bx);
              pg8::EpiGU E{act};
              pg8::gemm_phase<pg8::EpiGU, pg8::StaticOrder, PG8_ALIGN, PG8_SP2>(lds, g, S, E); }
#endif
        PH_END
        PH_BEGIN
#ifndef DIS_G8
            { pg8::Gemm g{act, Wd_t, TOK, 2048, DFF, DFF, DFF}; pg8::StaticOrder S; S.init(TOK, 2048, G, bx);
              pg8::EpiRes E{xres};
              pg8::gemm_phase<pg8::EpiRes, pg8::StaticOrder, PG8_ALIGN, PG8_SP2>(lds, g, S, E); }
#endif
        PH_END
        PH_BEGIN
            IDS
#ifndef DIS_LN
            for (int m = gw; m < TOK; m += NGW) ln_row(xres + (size_t)m * DM, xres + (size_t)m * DM, xb + (size_t)m * DM, IN(17) + l * DM, IN(18) + l * DM, lane);
#endif
#ifndef DIS_CVT
            if (l == 0) CVT_ATTN(1);
#endif
        PH_END
    }
}

#undef IN
#undef KARG
#undef x_in
#undef positions
#undef xres
#undef ssb
#undef Win_t
#undef Wuq_t
#undef Wkv_t
#undef Wout_t
#undef Wgu_t
#undef Wd_t
#undef cosT
#undef sinT
#undef hN
#undef hT
#undef xb
#undef Qb
#undef KR
#undef ST
#undef Kn
#undef VT
#undef act
#ifndef MK_SPLIT
#define MK_SPLIT 0
#endif
extern "C" void kernel_launch(void* const* d_in, const int* in_sizes, int n_in, void* d_out, int out_size, void* d_ws, size_t ws_size, hipStream_t stream) {
    static int grid = 0;
    if (grid == 0) {
        if (n_in != 19 || out_size != TOK * DM || ws_size < WS_END) { fprintf(stderr, "kernel_launch: unexpected shapes (n_in %d, out %d, ws %zu)\n", n_in, out_size, ws_size); grid = -1; return; }
        int dev = 0, cus = 0, per_cu = 0;
        (void)hipGetDevice(&dev); (void)hipDeviceGetAttribute(&cus, hipDeviceAttributeMultiprocessorCount, dev);
        if (hipFuncSetAttribute((const void*)mk_fwd, hipFuncAttributeMaxDynamicSharedMemorySize, LDS_BYTES) != hipSuccess) { fprintf(stderr, "kernel_launch: hipFuncSetAttribute failed\n"); grid = -1; return; }
        if (hipOccupancyMaxActiveBlocksPerMultiprocessor(&per_cu, (const void*)mk_fwd, 512, LDS_BYTES) != hipSuccess || per_cu < 1) { fprintf(stderr, "kernel_launch: occupancy query says %d\n", per_cu); per_cu = 1; }
        (void)hipGetLastError();
        grid = cus * 1;
        if (grid <= 0) grid = 256;
    }
    if (grid < 0) return;
    if (hipMemsetAsync((char*)d_ws + WS_BAR, 0, XCD_BAR_WORDS * 4, stream) != hipSuccess) { fprintf(stderr, "kernel_launch: memset failed\n"); return; }
    Args a{};
    for (int i = 0; i < 19; ++i) a.in[i] = (const float*)d_in[i];
    a.out = (float*)d_out; a.ws = (unsigned char*)d_ws;
#if MK_SPLIT
    for (int p = 0; p < NPH; ++p) { a.ph_lo = p; a.ph_hi = p + 1; void* args[] = {&a};
        hipError_t e = hipLaunchCooperativeKernel((const void*)mk_fwd, dim3(grid), dim3(512), args, LDS_BYTES, stream);
        if (e != hipSuccess) { fprintf(stderr, "launch %d failed: %s\n", p, hipGetErrorString(e)); break; } }
#else
    a.ph_lo = 0; a.ph_hi = NPH; void* args[] = {&a};
    hipError_t e = hipLaunchCooperativeKernel((const void*)mk_fwd, dim3(grid), dim3(512), args, LDS_BYTES, stream);
    if (e != hipSuccess) fprintf(stderr, "cooperative launch failed: %s (grid %d)\n", hipGetErrorString(e), grid);
#endif
}
```

```cpp
#include <hip/hip_runtime.h>
#include <hip/hip_cooperative_groups.h>
#include <cstdio>
#include <cstdint>
namespace cg = cooperative_groups;

typedef float f32x16 __attribute__((ext_vector_type(16)));
typedef unsigned u32x2 __attribute__((ext_vector_type(2)));
typedef float f32x2_t __attribute__((ext_vector_type(2)));
typedef __bf16 bf16x2_t __attribute__((ext_vector_type(2)));
__device__ __forceinline__ unsigned pk2(float lo, float hi) { f32x2_t v = {lo, hi}; bf16x2_t b = __builtin_convertvector(v, bf16x2_t); return __builtin_bit_cast(unsigned, b); }
__device__ __forceinline__ float bf_lo(unsigned w) { return __uint_as_float(w << 16); }
__device__ __forceinline__ float bf_hi(unsigned w) { return __uint_as_float(w & 0xffff0000u); }

constexpr int TOK = 16384, SEQ = 4096, DM = 2048, DFF = 5632;
constexpr float ALPHA = 1.4142135623730951f;
constexpr float QSCALE = 0.10411754627697264f;
__device__ __forceinline__ float lg2gamma(int h) { return h == 0 ? -0.04580368961312479f : h == 1 ? -0.02272007650008353f : h == 2 ? -0.011315313227834146f : -0.005646563141142063f; }
__device__ __forceinline__ float shx(float v, int mask, int lane) { return __int_as_float(__builtin_amdgcn_ds_bpermute((lane ^ mask) << 2, __float_as_int(v))); }
namespace pg8 {
#define PG8_LAS __attribute__((address_space(3)))
typedef unsigned short bf16_t;
typedef short bf16x8 __attribute__((ext_vector_type(8)));
typedef float f32x4 __attribute__((ext_vector_type(4)));
typedef unsigned u32x4 __attribute__((ext_vector_type(4)));
constexpr int BM = 256, BK = 64, HALF = 128, HTB = HALF * BK * 2  , STAGE_BYTES = 8 * HTB, NXCD = 8, WGM = 8;

__host__ __device__ __forceinline__ int lds_byte(int r, int c) { const int st = (r >> 4) * 2 + (c >> 5), rr = r & 15, cc = c & 31, ob = rr * 64 + cc * 2; return st * 1024 + (ob ^ (((ob >> 9) & 1) << 5)); }
__host__ __device__ __forceinline__ void stage_rc(int b, int& R, int& C) { const int st = b / 1024, sb = b % 1024, swz = sb ^ (((sb >> 9) & 1) << 5); R = (st >> 1) * 16 + swz / 64; C = (st & 1) * 32 + (swz % 64) / 2; }
__host__ __device__ __forceinline__ int perm32(int rho) { const int n = rho >> 4, i = rho & 15; return 8 * (i >> 2) + 4 * n + (i & 3); }

struct Unit { int pm, pn; };
struct Gemm { const bf16_t* A; const bf16_t* Bt; int M, N, K, lda, ldb; };

struct StaticOrder {
    int nM, nN, nwg, G, c;
    __host__ __device__ void init(int M, int N, int G_, int c_) { nM = M / BM; nN = N / BM; nwg = nM * nN; G = G_; c = c_; }
    __host__ __device__ bool next(int i, Unit& u) const {
        const long L = (long)i * G + c; if (L >= nwg) return false;
        int wgid = (int)L; { const int q = nwg / NXCD, r = nwg % NXCD, xcd = wgid % NXCD, off = wgid / NXCD; wgid = (xcd < r ? xcd * (q + 1) : r * (q + 1) + (xcd - r) * q) + off; }
        const int nig = WGM * nN, gid = wgid / nig, fm = gid * WGM, gsz = (nM - fm) < WGM ? (nM - fm) : WGM;
        u.pm = fm + ((wgid % nig) % gsz); u.pn = (wgid % nig) / gsz; return true;
    }
    __device__ __forceinline__ void a_ready(const Unit&) const {}
    __device__ __forceinline__ void done(const Unit&) const {}
};
__device__ __forceinline__ unsigned cvt_pk_bf16(float lo, float hi) { return pk2(lo, hi); }
__device__ __forceinline__ u32x4 pack8(const f32x4 a, const f32x4 b) { u32x4 w; w.x = pk2(a[0], a[1]); w.y = pk2(a[2], a[3]); w.z = pk2(b[0], b[1]); w.w = pk2(b[2], b[3]); return w; }
__device__ __forceinline__ float dot4(const f32x4 a) { return (a[0] * a[0] + a[1] * a[1]) + (a[2] * a[2] + a[3] * a[3]); }

struct EpiIn {
    static constexpr bool PERM = true, AFTER_DRAIN = false;
    bf16_t* hN; bf16_t* kr; float* ssq; float* sskv; const float* cosT; const float* sinT;
    __device__ __forceinline__ void operator()(const f32x4 (&acc)[2][2][4][2], const Unit& u, int wr, int wc, int fr, int fq) const {
        { int t_ = threadIdx.x; asm volatile("" : "+v"(t_)); fr = t_ & 15; fq = (t_ >> 4) & 3; }
        const int pn = u.pn, row0 = u.pm * BM + wr * 64 + fr, cl = wc * 32 + 8 * fq;
        if (pn >= 8) {
            const float sc = pn < 12 ? 0.0625f : 1.0f;
#pragma unroll
            for (int ai = 0; ai < 2; ++ai)
#pragma unroll
                for (int m = 0; m < 4; ++m) {
                    const int row = row0 + ai * HALF + m * 16;
                    const float* cp = cosT + (size_t)row * 128 + cl; const float* sp = sinT + (size_t)row * 128 + cl;
                    const f32x4 c0 = *(const f32x4*)cp, c1 = *(const f32x4*)(cp + 4), s0 = *(const f32x4*)sp, s1 = *(const f32x4*)(sp + 4);
                    const f32x4 a0 = acc[ai][0][m][0], a1 = acc[ai][0][m][1], b0 = acc[ai][1][m][0], b1 = acc[ai][1][m][1];
                    const f32x4 o10 = (a0 * c0 - b0 * s0) * sc, o11 = (a1 * c1 - b1 * s1) * sc, o20 = (b0 * c0 + a0 * s0) * sc, o21 = (b1 * c1 + a1 * s1) * sc;
                    bf16_t* p = hN + (size_t)row * 4096 + pn * 256 + cl;
                    *(u32x4*)p = pack8(o10, o11); *(u32x4*)(p + 128) = pack8(o20, o21); asm volatile("" ::: "memory");
                }
        } else if (pn == 3) {
            if (wc == 0) {
#pragma unroll
                for (int ai = 0; ai < 2; ++ai)
#pragma unroll
                    for (int m = 0; m < 4; ++m) {
                        const int row = row0 + ai * HALF + m * 16;
                        const float* cp = cosT + (size_t)row * 128 + 32 * fq; const float* sp = sinT + (size_t)row * 128 + 32 * fq;
                        f32x4 c0, c1, s0, s1;
#pragma unroll
                        for (int j = 0; j < 4; ++j) { c0[j] = cp[4 * j]; c1[j] = cp[16 + 4 * j]; s0[j] = sp[4 * j]; s1[j] = sp[16 + 4 * j]; }
                        const f32x4 a0 = acc[ai][0][m][0], a1 = acc[ai][0][m][1], b0 = acc[ai][1][m][0], b1 = acc[ai][1][m][1];
                        const f32x4 o10 = a0 * c0 - b0 * s0, o11 = a1 * c1 - b1 * s1, o20 = b0 * c0 + a0 * s0, o21 = b1 * c1 + a1 * s1;
                        bf16_t* p = kr + (size_t)row * 64 + 8 * fq;
                        *(u32x4*)p = pack8(o10, o11); *(u32x4*)(p + 32) = pack8(o20, o21); asm volatile("" ::: "memory");
                    }
            }
        } else {
            float* ss = pn < 2 ? ssq : sskv;
#pragma unroll
            for (int ai = 0; ai < 2; ++ai)
#pragma unroll
                for (int m = 0; m < 4; ++m) {
                    const int row = row0 + ai * HALF + m * 16; float s = 0.f;
#pragma unroll
                    for (int bj = 0; bj < 2; ++bj) {
                        const f32x4 v0 = acc[ai][bj][m][0], v1 = acc[ai][bj][m][1];
                        *(u32x4*)(hN + (size_t)row * 4096 + pn * 256 + bj * HALF + cl) = pack8(v0, v1);
                        s += dot4(v0) + dot4(v1);
                    }
                    if (pn < 3) { s += shx(s, 16, fq * 16 + fr); s += shx(s, 32, fq * 16 + fr); if (fq == 0) atomicAdd(ss + row, s); }
                }
        }
    }
};
struct EpiInT {
    static constexpr bool PERM = true, AFTER_DRAIN = false;
    bf16_t* hT; const float* cosT; const float* sinT;
    __device__ __forceinline__ void operator()(const f32x4 (&acc)[2][2][4][2], const Unit& u, int wr, int wc, int fr, int fq) const {
        { int t_ = threadIdx.x; asm volatile("" : "+v"(t_)); fr = t_ & 15; fq = (t_ >> 4) & 3; }
        const int pm = u.pm, tok0 = u.pn * BM + wc * 32 + 8 * fq;
        if (pm < 4) {
            const float lg2 = lg2gamma(pm);
#pragma unroll
            for (int m = 0; m < 4; ++m) {
                const int i = wr * 64 + m * 16 + fr;
#pragma unroll
                for (int bj = 0; bj < 2; ++bj) {
                    const int tok = tok0 + bj * HALF;
                    f32x4 o1[2], o2[2];
#pragma unroll
                    for (int n = 0; n < 2; ++n)
#pragma unroll
                        for (int j = 0; j < 4; ++j) {
                            const int t = tok + 4 * n + j;
                            const float c = cosT[(size_t)t * 128 + i], s = sinT[(size_t)t * 128 + i];
                            const float dec = __builtin_amdgcn_exp2f(lg2 * (float)(63 - (t & 63)));
                            const float t1 = acc[0][bj][m][n][j], t2 = acc[1][bj][m][n][j];
                            o1[n][j] = (t1 * c - t2 * s) * dec; o2[n][j] = (t2 * c + t1 * s) * dec;
                        }
                    *(u32x4*)(hT + (size_t)(pm * 256 + i) * TOK + tok) = pack8(o1[0], o1[1]);
                    *(u32x4*)(hT + (size_t)(pm * 256 + 128 + i) * TOK + tok) = pack8(o2[0], o2[1]); asm volatile("" ::: "memory");
                }
            }
        } else {
#pragma unroll
            for (int ai = 0; ai < 2; ++ai)
#pragma unroll
                for (int m = 0; m < 4; ++m) {
                    const int r = pm * 256 + ai * HALF + wr * 64 + m * 16 + fr;
#pragma unroll
                    for (int bj = 0; bj < 2; ++bj) *(u32x4*)(hT + (size_t)r * TOK + tok0 + bj * HALF) = pack8(acc[ai][bj][m][0], acc[ai][bj][m][1]);
                }
        }
    }
};
struct EpiQ {
    static constexpr bool PERM = true, AFTER_DRAIN = false;
    bf16_t* Q; const float* ssq; const float* cosT; const float* sinT;
    __device__ __forceinline__ void operator()(const f32x4 (&acc)[2][2][4][2], const Unit& u, int wr, int wc, int fr, int fq) const {
        { int t_ = threadIdx.x; asm volatile("" : "+v"(t_)); fr = t_ & 15; fq = (t_ >> 4) & 3; }
        const int pn = u.pn, row0 = u.pm * BM + wr * 64 + fr;
#pragma unroll
        for (int ai = 0; ai < 2; ++ai)
#pragma unroll
            for (int m = 0; m < 4; ++m) {
                const int row = row0 + ai * HALF + m * 16;
                const float rs = rsqrtf(ssq[row] * (1.0f / 512.0f) + 1e-6f) * QSCALE;
                if (pn < 4) {
#pragma unroll
                    for (int bj = 0; bj < 2; ++bj)
                        *(u32x4*)(Q + (size_t)row * 1536 + (2 * pn + bj) * 192 + wc * 32 + 8 * fq) = pack8(acc[ai][bj][m][0] * rs, acc[ai][bj][m][1] * rs);
                } else {
                    const float* cp = cosT + (size_t)row * 128 + 32 * fq; const float* sp = sinT + (size_t)row * 128 + 32 * fq;
                    f32x4 c0, c1, s0, s1;
#pragma unroll
                    for (int j = 0; j < 4; ++j) { c0[j] = cp[4 * j]; c1[j] = cp[16 + 4 * j]; s0[j] = sp[4 * j]; s1[j] = sp[16 + 4 * j]; }
                    const f32x4 a0 = acc[ai][0][m][0] * rs, a1 = acc[ai][0][m][1] * rs, b0 = acc[ai][1][m][0] * rs, b1 = acc[ai][1][m][1] * rs;
                    const f32x4 o10 = a0 * c0 - b0 * s0, o11 = a1 * c1 - b1 * s1, o20 = b0 * c0 + a0 * s0, o21 = b1 * c1 + a1 * s1;
                    bf16_t* p = Q + (size_t)row * 1536 + (4 * (pn - 4) + wc) * 192 + 128 + 8 * fq;
                    *(u32x4*)p = pack8(o10, o11); *(u32x4*)(p + 32) = pack8(o20, o21); asm volatile("" ::: "memory");
                }
            }
    }
};
struct EpiK {
    static constexpr bool PERM = true, AFTER_DRAIN = false;
    bf16_t* Kn; const float* sskv;
    __device__ __forceinline__ void operator()(const f32x4 (&acc)[2][2][4][2], const Unit& u, int wr, int wc, int fr, int fq) const {
        { int t_ = threadIdx.x; asm volatile("" : "+v"(t_)); fr = t_ & 15; fq = (t_ >> 4) & 3; }
        const int row0 = u.pm * BM + wr * 64 + fr, col0 = u.pn * BM + wc * 32 + 8 * fq;
#pragma unroll
        for (int ai = 0; ai < 2; ++ai)
#pragma unroll
            for (int m = 0; m < 4; ++m) {
                const int row = row0 + ai * HALF + m * 16;
                const float rs = rsqrtf(sskv[row] * (1.0f / 256.0f) + 1e-6f);
#pragma unroll
                for (int bj = 0; bj < 2; ++bj) *(u32x4*)(Kn + (size_t)row * 1024 + col0 + bj * HALF) = pack8(acc[ai][bj][m][0] * rs, acc[ai][bj][m][1] * rs);
            }
    }
};
struct EpiVT {
    static constexpr bool PERM = true, AFTER_DRAIN = false;
    bf16_t* VT; const float* sskv;
    __device__ __forceinline__ void operator()(const f32x4 (&acc)[2][2][4][2], const Unit& u, int wr, int wc, int fr, int fq) const {
        { int t_ = threadIdx.x; asm volatile("" : "+v"(t_)); fr = t_ & 15; fq = (t_ >> 4) & 3; }
        const int tok0 = u.pn * BM + wc * 32 + 8 * fq;
        f32x4 rs[2][2];
#pragma unroll
        for (int bj = 0; bj < 2; ++bj)
#pragma unroll
            for (int n = 0; n < 2; ++n) { const f32x4 s = *(const f32x4*)(sskv + tok0 + bj * HALF + 4 * n);
#pragma unroll
                for (int j = 0; j < 4; ++j) rs[bj][n][j] = rsqrtf(s[j] * (1.0f / 256.0f) + 1e-6f); }
#pragma unroll
        for (int ai = 0; ai < 2; ++ai)
#pragma unroll
            for (int m = 0; m < 4; ++m) {
                const int r = u.pm * BM + ai * HALF + wr * 64 + m * 16 + fr;
#pragma unroll
                for (int bj = 0; bj < 2; ++bj) *(u32x4*)(VT + (size_t)r * TOK + tok0 + bj * HALF) = pack8(acc[ai][bj][m][0] * rs[bj][0], acc[ai][bj][m][1] * rs[bj][1]);
            }
    }
};
struct EpiRes {
    static constexpr bool PERM = true, AFTER_DRAIN = false;
    float* x;
    __device__ __forceinline__ void operator()(const f32x4 (&acc)[2][2][4][2], const Unit& u, int wr, int wc, int fr, int fq) const {
        { int t_ = threadIdx.x; asm volatile("" : "+v"(t_)); fr = t_ & 15; fq = (t_ >> 4) & 3; }
        const int row0 = u.pm * BM + wr * 64 + fr, col0 = u.pn * BM + wc * 32 + 8 * fq;
#pragma unroll
        for (int ai = 0; ai < 2; ++ai)
#pragma unroll
            for (int m = 0; m < 4; ++m) {
                float* rp = x + (size_t)(row0 + ai * HALF + m * 16) * DM + col0;
#pragma unroll
                for (int bj = 0; bj < 2; ++bj)
#pragma unroll
                    for (int n = 0; n < 2; ++n) { f32x4* p = (f32x4*)(rp + bj * HALF + 4 * n); *p = *p * ALPHA + acc[ai][bj][m][n]; }
                asm volatile("" ::: "memory");
            }
    }
};
struct EpiGU {
    static constexpr bool PERM = true, AFTER_DRAIN = false;
    bf16_t* act;
    __device__ __forceinline__ void operator()(const f32x4 (&acc)[2][2][4][2], const Unit& u, int wr, int wc, int fr, int fq) const {
        { int t_ = threadIdx.x; asm volatile("" : "+v"(t_)); fr = t_ & 15; fq = (t_ >> 4) & 3; }
        const int row0 = u.pm * BM + wr * 64 + fr, col0 = u.pn * 128 + wc * 16 + 4 * fq;
#pragma unroll
        for (int ai = 0; ai < 2; ++ai)
#pragma unroll
            for (int m = 0; m < 4; ++m) {
                bf16_t* rp = act + (size_t)(row0 + ai * HALF + m * 16) * DFF + col0;
#pragma unroll
                for (int bj = 0; bj < 2; ++bj) {
                    const f32x4 g = acc[ai][bj][m][0], up = acc[ai][bj][m][1]; f32x4 o;
#pragma unroll
                    for (int j = 0; j < 4; ++j) o[j] = g[j] * __builtin_amdgcn_rcpf(1.0f + __builtin_amdgcn_exp2f(-1.4426950408889634f * g[j])) * up[j];
                    u32x2 w; w.x = pk2(o[0], o[1]); w.y = pk2(o[2], o[3]);
                    *(u32x2*)(rp + bj * 64) = w;
                }
            }
    }
};

template <class Epi, class Sched, bool ALIGN_EPI = false, bool SP2 = false>
__device__ __forceinline__ void gemm_phase(PG8_LAS unsigned char* lds, const Gemm g, const Sched& S, const Epi& E) {
    int tid_ = threadIdx.x; asm volatile("" : "+v"(tid_));
    const int tid = tid_, wid = __builtin_amdgcn_readfirstlane(tid >> 6), lane = tid & 63, wr = wid >> 2, wc = wid & 3, fr = lane & 15, fq = lane >> 4;
    const int K = g.K, nt = K / BK;
    unsigned voffA[2], voffB[2];
#pragma unroll
    for (int i = 0; i < 2; ++i) { int R, C; stage_rc(tid * 16 + i * 8192, R, C); const int Rb = Epi::PERM ? ((R & ~31) + perm32(R & 31)) : R;
        voffA[i] = (unsigned)(R * g.lda + C) * 2u; voffB[i] = (unsigned)(Rb * g.ldb + C) * 2u; }
    const size_t kstep = (size_t)(BK * 2);
    const size_t hstepA = (size_t)HALF * g.lda * 2, hstepB = (size_t)HALF * g.ldb * 2;
    const size_t tstepA = 2 * hstepA, tstepB = 2 * hstepB;
    const unsigned ldsw = (unsigned)wid * 1024u;
    const int aoff = lds_byte(wr * 64 + fr, fq * 8), boff = lds_byte(wc * 32 + fr, fq * 8);
#define PG8_SA(b, h) (((b) * 2 + (h)) * HTB)
#define PG8_SB(b, h) ((4 + (b) * 2 + (h)) * HTB)
#define PG8_STAGE(bufoff, gbase, voff) do { _Pragma("unroll") for (int _i = 0; _i < 2; ++_i) \
        __builtin_amdgcn_global_load_lds((const unsigned*)((const char*)(gbase) + (voff)[_i]), (PG8_LAS unsigned*)(lds + (bufoff) + ldsw + _i * 8192), 16, 0, 0); } while (0)
#define PG8_LDA(dst, b, h) do { _Pragma("unroll") for (int m = 0; m < 4; ++m) _Pragma("unroll") for (int k = 0; k < 2; ++k) dst[m][k] = *(const PG8_LAS bf16x8*)(lds + PG8_SA(b, h) + aoff + m * 2048 + k * 1024); } while (0)
#define PG8_LDB(dst, b, h) do { _Pragma("unroll") for (int n = 0; n < 2; ++n) _Pragma("unroll") for (int k = 0; k < 2; ++k) dst[n][k] = *(const PG8_LAS bf16x8*)(lds + PG8_SB(b, h) + boff + n * 2048 + k * 1024); } while (0)
#define PG8_MMA(ai, bj, At, Bt) do { __builtin_amdgcn_s_setprio(1); _Pragma("unroll") for (int m = 0; m < 4; ++m) _Pragma("unroll") for (int n = 0; n < 2; ++n) _Pragma("unroll") for (int k = 0; k < 2; ++k) \
        acc[ai][bj][m][n] = __builtin_amdgcn_mfma_f32_16x16x32_bf16(Bt[n][k], At[m][k], acc[ai][bj][m][n], 0, 0, 0); __builtin_amdgcn_s_setprio(0); } while (0)
#define PG8_WAIT_V(n) asm volatile("s_waitcnt vmcnt(" #n ")" ::: "memory")
#define PG8_WAIT_L(n) asm volatile("s_waitcnt lgkmcnt(" #n ")" ::: "memory")
#define PG8_BAR __builtin_amdgcn_s_barrier()
#define PG8_SCHED __builtin_amdgcn_sched_barrier(0)
    Unit cur, nxt; int ui = 0;
    if (!S.next(0, cur)) return;
    f32x4 acc[2][2][4][2];
#pragma unroll
    for (int a = 0; a < 2; ++a)
#pragma unroll
        for (int b = 0; b < 2; ++b)
#pragma unroll
            for (int m = 0; m < 4; ++m)
#pragma unroll
                for (int n = 0; n < 2; ++n) acc[a][b][m][n] = (f32x4){0.f, 0.f, 0.f, 0.f};
    bf16x8 At[4][2], B0[2][2], B1[2][2];
    const char* cA = (const char*)g.A + (size_t)cur.pm * tstepA; const char* cB = (const char*)g.Bt + (size_t)cur.pn * tstepB;
    S.a_ready(cur);
    if constexpr (SP2) {
        PG8_STAGE(PG8_SB(0, 0), cB, voffB); PG8_STAGE(PG8_SB(0, 1), cB + hstepB, voffB); PG8_STAGE(PG8_SA(0, 0), cA, voffA); PG8_STAGE(PG8_SA(0, 1), cA + hstepA, voffA);
        if (wr == 1) PG8_BAR;
        PG8_WAIT_V(2); PG8_BAR;
        PG8_STAGE(PG8_SB(1, 0), cB + kstep, voffB); PG8_STAGE(PG8_SA(1, 0), cA + kstep, voffA); PG8_STAGE(PG8_SB(1, 1), cB + hstepB + kstep, voffB);
        PG8_WAIT_V(6); PG8_BAR;
    } else {
        PG8_STAGE(PG8_SB(0, 0), cB, voffB); PG8_STAGE(PG8_SA(0, 0), cA, voffA); PG8_STAGE(PG8_SB(0, 1), cB + hstepB, voffB); PG8_STAGE(PG8_SA(0, 1), cA + hstepA, voffA);
        if (wr == 1) PG8_BAR;
        PG8_WAIT_V(4); PG8_BAR;
        PG8_STAGE(PG8_SB(1, 0), cB + kstep, voffB); PG8_STAGE(PG8_SA(1, 0), cA + kstep, voffA); PG8_STAGE(PG8_SB(1, 1), cB + hstepB + kstep, voffB);
        PG8_WAIT_V(6); PG8_BAR;
    }
    for (;;) {
        const bool has_next = S.next(ui + 1, nxt);
        const char* nA = has_next ? (const char*)g.A + (size_t)nxt.pm * tstepA : cA; const char* nB = has_next ? (const char*)g.Bt + (size_t)nxt.pn * tstepB : cB;
        for (int t = 0; t < nt; t += 2) {
            const bool last = (t == nt - 2);
            const char* a1 = cA + (size_t)(t + 1) * kstep;
            const char* a2 = last ? nA : cA + (size_t)(t + 2) * kstep; const char* b2 = last ? nB : cB + (size_t)(t + 2) * kstep;
            const char* a3 = a2 + kstep; const char* b3 = b2 + kstep;
            if (last && has_next) S.a_ready(nxt);
            if constexpr (SP2) {
            PG8_LDB(B0, 0, 0); PG8_LDB(B1, 0, 1); PG8_SCHED; PG8_LDA(At, 0, 0); PG8_STAGE(PG8_SA(1, 1), a1 + hstepA, voffA);
            PG8_WAIT_V(8); PG8_WAIT_L(0); PG8_BAR; PG8_MMA(0, 0, At, B0); PG8_MMA(0, 1, At, B1); PG8_BAR; PG8_SCHED;
            PG8_LDA(At, 0, 1); PG8_STAGE(PG8_SB(0, 0), b2, voffB); PG8_STAGE(PG8_SB(0, 1), b2 + hstepB, voffB); PG8_STAGE(PG8_SA(0, 0), a2, voffA);
            PG8_WAIT_V(8); PG8_WAIT_L(0); PG8_BAR; PG8_MMA(1, 0, At, B0); PG8_MMA(1, 1, At, B1); PG8_BAR; PG8_SCHED;
            PG8_LDB(B0, 1, 0); PG8_LDB(B1, 1, 1); PG8_SCHED; PG8_LDA(At, 1, 0); PG8_STAGE(PG8_SA(0, 1), a2 + hstepA, voffA);
            PG8_WAIT_V(8); PG8_WAIT_L(0); PG8_BAR; PG8_MMA(0, 0, At, B0); PG8_MMA(0, 1, At, B1); PG8_BAR; PG8_SCHED;
            PG8_LDA(At, 1, 1); PG8_STAGE(PG8_SB(1, 0), b3, voffB); PG8_STAGE(PG8_SB(1, 1), b3 + hstepB, voffB); PG8_STAGE(PG8_SA(1, 0), a3, voffA);
            PG8_WAIT_V(8); PG8_WAIT_L(0); PG8_BAR; PG8_MMA(1, 0, At, B0); PG8_MMA(1, 1, At, B1); PG8_BAR; PG8_SCHED;
            } else {
            PG8_LDB(B0, 0, 0); PG8_SCHED; PG8_LDA(At, 0, 0); PG8_STAGE(PG8_SA(1, 1), a1 + hstepA, voffA);
            PG8_WAIT_L(8); PG8_BAR; PG8_WAIT_L(0); PG8_MMA(0, 0, At, B0); PG8_BAR; PG8_SCHED;
            PG8_LDB(B1, 0, 1); PG8_STAGE(PG8_SB(0, 0), b2, voffB);
            PG8_BAR; PG8_WAIT_L(0); PG8_MMA(0, 1, At, B1); PG8_BAR;
            PG8_LDA(At, 0, 1); PG8_STAGE(PG8_SA(0, 0), a2, voffA);
            PG8_BAR; PG8_WAIT_L(0); PG8_MMA(1, 0, At, B0); PG8_BAR; PG8_SCHED;
            PG8_STAGE(PG8_SB(0, 1), b2 + hstepB, voffB);
            PG8_WAIT_V(6); PG8_BAR; PG8_MMA(1, 1, At, B1); PG8_BAR;
            PG8_LDB(B0, 1, 0); PG8_SCHED; PG8_LDA(At, 1, 0); PG8_STAGE(PG8_SA(0, 1), a2 + hstepA, voffA);
            PG8_WAIT_L(8); PG8_BAR; PG8_WAIT_L(0); PG8_MMA(0, 0, At, B0); PG8_BAR; PG8_SCHED;
            PG8_LDB(B1, 1, 1); PG8_STAGE(PG8_SB(1, 0), b3, voffB);
            PG8_BAR; PG8_WAIT_L(0); PG8_MMA(0, 1, At, B1); PG8_BAR;
            PG8_LDA(At, 1, 1); PG8_STAGE(PG8_SA(1, 0), a3, voffA);
            PG8_BAR; PG8_WAIT_L(0); PG8_MMA(1, 0, At, B0); PG8_BAR; PG8_SCHED;
            PG8_STAGE(PG8_SB(1, 1), b3 + hstepB, voffB);
            PG8_WAIT_V(6); PG8_BAR; PG8_MMA(1, 1, At, B1); PG8_BAR;
            }
        }
        if constexpr (ALIGN_EPI) { if (wr == 0) PG8_BAR; }
        if constexpr (!Epi::AFTER_DRAIN) { E(acc, cur, wr, wc, fr, fq); S.done(cur); }
        if (!has_next) break;
#pragma unroll
        for (int a = 0; a < 2; ++a)
#pragma unroll
            for (int b = 0; b < 2; ++b)
#pragma unroll
                for (int m = 0; m < 4; ++m)
#pragma unroll
                    for (int n = 0; n < 2; ++n) acc[a][b][m][n] = (f32x4){0.f, 0.f, 0.f, 0.f};
        cur = nxt; cA = nA; cB = nB; ++ui;
        if constexpr (ALIGN_EPI) { if (wr == 1) PG8_BAR; }
    }
    PG8_WAIT_V(0);
    if constexpr (!ALIGN_EPI) { if (wr == 0) PG8_BAR; }
    PG8_BAR;
    if constexpr (Epi::AFTER_DRAIN) { E.fused(acc, cur, wr, wc, fr, fq, lds, wid, lane); S.done(cur); }
#undef PG8_SA
#undef PG8_SB
#undef PG8_STAGE
#undef PG8_LDA
#undef PG8_LDB
#undef PG8_MMA
#undef PG8_WAIT_V
#undef PG8_WAIT_L
#undef PG8_BAR
#undef PG8_SCHED
}
}
#define PG8_SP2 true
#define PG8_ALIGN true

#define LAS __attribute__((address_space(3)))
using pg8::bf16_t; using pg8::bf16x8; using pg8::f32x4; using pg8::u32x4;
#define MFMA32(a, b, c) __builtin_amdgcn_mfma_f32_32x32x16_bf16((a), (b), (c), 0, 0, 0)
constexpr size_t MiB = 1u << 20;
constexpr size_t WS_SS = 0;
constexpr size_t WS_BAR = 512 * 1024;
constexpr size_t WS_WIN = 1 * MiB;
constexpr size_t WS_WUQ = 25 * MiB;
constexpr size_t WS_WKV = 26 * MiB + 512 * 1024;
constexpr size_t WS_WOUT = 28 * MiB;
constexpr size_t WS_TAB = 36 * MiB;
constexpr size_t WS_HN = 52 * MiB;
constexpr size_t WS_HT = 180 * MiB;
constexpr size_t WS_XB = 244 * MiB;
constexpr size_t WS_Q = 244 * MiB, WS_KR = 500 * MiB;
constexpr size_t WS_ST = 308 * MiB;
constexpr size_t WS_WGU = 308 * MiB, WS_WD = 352 * MiB;
constexpr size_t WS_KN = 436 * MiB;
constexpr size_t WS_VT = 468 * MiB;
constexpr size_t WS_ACT = 52 * MiB;
constexpr size_t WS_END = 502 * MiB;
constexpr int LDS_BYTES = 131072 + 1024;
constexpr int NPH = 17;

__device__ __forceinline__ float wave_sum(float v, int lane) {
#pragma unroll
    for (int o = 1; o < 64; o <<= 1) v += shx(v, o, lane);
    return v;
}
#define XB_TMO      128
#define XB_XCNT(j)  (256  + 64 * (j))
#define XB_XSUB(j)  (1280 + 64 * (j))
#define XB_XGEN(j)  (2304 + 64 * (j))
#define XB_TOP      3328
#define XB_TOPGEN   3392
#define XCD_BAR_WORDS 3456
#define XB_SPIN_CAP (1u << 18)

__device__ __forceinline__ unsigned xb_ld(unsigned* p)              { return __hip_atomic_load(p, __ATOMIC_RELAXED, __HIP_MEMORY_SCOPE_AGENT); }
__device__ __forceinline__ unsigned xb_add(unsigned* p, unsigned v) { return __hip_atomic_fetch_add(p, v, __ATOMIC_RELAXED, __HIP_MEMORY_SCOPE_AGENT); }
__device__ __forceinline__ unsigned xb_xcc_id() { return (unsigned)__builtin_amdgcn_s_getreg((3 << 11) | 20) & 0xFu; }
#define XB_SPIN(cond, bar) do { unsigned _sp = 0; while (cond) { __builtin_amdgcn_s_sleep(1); \
    if ((++_sp & 255u) == 0u) { if (xb_ld(&(bar)[XB_TMO])) break; if (_sp > XB_SPIN_CAP) { atomicAdd(&(bar)[XB_TMO], 1u); break; } } } } while (0)

struct XcdBarrier {
    unsigned* bar; unsigned x;
    volatile LAS unsigned* st;
};

__device__ __forceinline__ XcdBarrier xcd_barrier_post(unsigned* bar, volatile LAS unsigned* st) {
    XcdBarrier b; b.bar = bar; b.x = xb_xcc_id(); b.st = st;
    if (threadIdx.x == 0) (void)xb_add(&bar[XB_XCNT(b.x)], 1u);
    return b;
}
__device__ __forceinline__ void xcd_barrier_complete(unsigned* bar, unsigned x, unsigned& nloc, unsigned& nx) {
    const unsigned G = gridDim.x * gridDim.y * gridDim.z;
    unsigned sum, cnt, mine, sp = 0u;
    for (;;) {
        sum = 0u; cnt = 0u; mine = 0u;
#pragma unroll
        for (unsigned j = 0; j < 16; ++j) { const unsigned c = xb_ld(&bar[XB_XCNT(j)]); sum += c; cnt += (c > 0u) ? 1u : 0u; mine = (j == x) ? c : mine; }
        if (sum == G) break;
        __builtin_amdgcn_s_sleep(1);
        if ((++sp & 255u) == 0u) { if (xb_ld(&bar[XB_TMO])) break; if (sp > XB_SPIN_CAP) { atomicAdd(&bar[XB_TMO], 1u); break; } }
    }
    nloc = mine > 0u ? mine : 1u; nx = cnt > 0u ? cnt : 1u;
}

__device__ __forceinline__ void xcd_barrier(const XcdBarrier& b) {
    asm volatile("s_waitcnt vmcnt(0)" ::: "memory");
    __syncthreads();
    if (threadIdx.x == 0) {
        unsigned* bar = b.bar;
        __builtin_amdgcn_s_waitcnt(0);
        unsigned nloc = b.st[0], nx = b.st[1];
        if (nloc == 0u) { xcd_barrier_complete(bar, b.x, nloc, nx); b.st[0] = nloc; b.st[1] = nx; }
        const unsigned old = xb_add(&bar[XB_XSUB(b.x)], 1u);
        const unsigned gen = old / nloc;
        if (old + 1u == (gen + 1u) * nloc) {
            __builtin_amdgcn_fence(__ATOMIC_RELEASE, "agent");
            asm volatile("s_waitcnt vmcnt(0)" ::: "memory");
            const unsigned og = xb_add(&bar[XB_TOP], 1u);
            const unsigned tg = og / nx;
            if (og + 1u == (tg + 1u) * nx) xb_add(&bar[XB_TOPGEN], 1u);
            else XB_SPIN(xb_ld(&bar[XB_TOPGEN]) == tg, bar);
            __builtin_amdgcn_fence(__ATOMIC_ACQUIRE, "agent");
            xb_add(&bar[XB_XGEN(b.x)], 1u);
            asm volatile("s_waitcnt vmcnt(0)" ::: "memory");
        } else {
            XB_SPIN(xb_ld(&bar[XB_XGEN(b.x)]) == gen, bar);
            __builtin_amdgcn_fence(__ATOMIC_ACQUIRE, "agent");
            asm volatile("s_waitcnt vmcnt(0)" ::: "memory");
        }
    }
    __syncthreads();
}

template <int MODE> __device__ __forceinline__ void rowmap(int n, int& r1, int& r2) {
    r2 = -1;
    if (MODE == 0) {
        if (n < 800) r1 = n;
        else if (n < 832) r1 = n + 96;
        else if (n < 1856) r1 = 2048 + (n - 832);
        else if (n < 2880) { r1 = 3072 + (n - 1856); r2 = 4096 + (n - 1856); }
        else if (n < 3904) r1 = 5120 + (n - 2880);
        else r1 = 1024 + (n - 3904);
    } else if (MODE == 1) {
        const int h = n / 192, d = n % 192;
        if (d < 128) r1 = (h >> 1) * 256 + (h & 1) * 128 + d;
        else { const int i = d - 128; r1 = 1024 + (h >> 2) * 256 + (i >> 5) * 128 + (h & 3) * 32 + (i & 31); }
    } else if (MODE == 2) {
        const int h = n >> 8, d = n & 255;
        r1 = d < 128 ? h * 128 + d : 1024 + h * 128 + (d - 128);
    } else if (MODE == 3) r1 = n;
    else if (MODE == 4) r1 = 8 * (n >> 2) + (n & 3);
    else r1 = 8 * (n >> 2) + 4 + (n & 3);
}
template <int MODE> __device__ __forceinline__ void cvt_item(const float* __restrict__ W, int K, int N, const float* __restrict__ ksc, bf16_t* WT, LAS float* scr, int item, int lane) {
    const int nblk = N / 32, kb = item / nblk, nb = item % nblk, k0 = 64 * kb, n0 = 32 * nb;
#pragma unroll 8
    for (int i = 0; i < 32; ++i) { const int kk = 2 * i + (lane >> 5); float v = W[(size_t)(k0 + kk) * N + n0 + (lane & 31)]; if (ksc) v *= ksc[k0 + kk]; scr[kk * 33 + (lane & 31)] = v; }
    asm volatile("s_waitcnt lgkmcnt(0)" ::: "memory");
    const int c = lane & 7;
#pragma unroll
    for (int j = 0; j < 4; ++j) {
        const int n = (lane >> 3) + 8 * j; const LAS float* s = scr + (8 * c) * 33 + n;
        u32x4 o; o.x = pk2(s[0 * 33], s[1 * 33]); o.y = pk2(s[2 * 33], s[3 * 33]); o.z = pk2(s[4 * 33], s[5 * 33]); o.w = pk2(s[6 * 33], s[7 * 33]);
        int r1, r2; rowmap<MODE>(n0 + n, r1, r2);
        *(u32x4*)(WT + (size_t)r1 * K + k0 + 8 * c) = o;
        if (MODE == 0) { if (r2 >= 0) *(u32x4*)(WT + (size_t)r2 * K + k0 + 8 * c) = o; }
    }
    asm volatile("s_waitcnt lgkmcnt(0)" ::: "memory");
}
__device__ __forceinline__ void ln_row(const float* src, float* dstf, bf16_t* dstb, const float* __restrict__ g, const float* __restrict__ b, int lane) {
    f32x4 v[8]; float s = 0.f;
#pragma unroll
    for (int j = 0; j < 8; ++j) { v[j] = ((const f32x4*)src)[lane + 64 * j]; s += (v[j][0] + v[j][1]) + (v[j][2] + v[j][3]); }
    const float mean = wave_sum(s, lane) * (1.0f / 2048.0f); float s2 = 0.f;
#pragma unroll
    for (int j = 0; j < 8; ++j) { v[j] = v[j] - mean; s2 += pg8::dot4(v[j]); }
    const float rstd = rsqrtf(wave_sum(s2, lane) * (1.0f / 2048.0f) + 1e-5f);
#pragma unroll
    for (int j = 0; j < 8; ++j) {
        const f32x4 gg = ((const f32x4*)g)[lane + 64 * j], bb = ((const f32x4*)b)[lane + 64 * j];
        const f32x4 o = v[j] * rstd * gg + bb;
        ((f32x4*)dstf)[lane + 64 * j] = o;
        u32x2 w; w.x = pk2(o[0], o[1]); w.y = pk2(o[2], o[3]);
        ((u32x2*)dstb)[lane + 64 * j] = w;
    }
}
__device__ __forceinline__ int sig32(int r) { return (r & 0x13) | ((r & 4) << 1) | ((r & 8) >> 1); }
__device__ __forceinline__ bf16x8 pack_half(const f32x16& x, int s) {
    u32x4 p; p.x = pk2(x[8 * s + 0], x[8 * s + 1]); p.y = pk2(x[8 * s + 2], x[8 * s + 3]); p.z = pk2(x[8 * s + 4], x[8 * s + 5]); p.w = pk2(x[8 * s + 6], x[8 * s + 7]);
    return __builtin_bit_cast(bf16x8, p);
}
__device__ __forceinline__ f32x16 zero16() { f32x16 z;
#pragma unroll
    for (int i = 0; i < 16; ++i) z[i] = 0.f; return z; }

__device__ __forceinline__ bf16x8 ldf(const bf16_t* ub, unsigned off) { return *(const bf16x8*)((const char*)ub + off); }
__device__ __forceinline__ u32x2 ld8(const bf16_t* ub, unsigned off) { return *(const u32x2*)((const char*)ub + off); }
__device__ __forceinline__ void st8(bf16_t* ub, unsigned off, u32x2 v) { *(u32x2*)((char*)ub + off) = v; }

__device__ __forceinline__ void scan_wave(const bf16_t* __restrict__ hT, bf16_t* __restrict__ ST, int wt, int lane) {
    asm volatile("" : "+v"(lane));
    const int r32 = lane & 31, hi = lane >> 5;
    const int bh = wt >> 6, it = (wt >> 3) & 7, jt = wt & 7, h = bh & 3, b = bh >> 2;
    const bf16_t* kd = hT + (size_t)(h * 256 + 32 * it) * TOK + (size_t)b * SEQ;
    const bf16_t* vv = hT + (size_t)(1024 + h * 256 + 32 * jt) * TOK + (size_t)b * SEQ;
    const unsigned lo = (unsigned)(r32 * TOK + 8 * hi) * 2u;
    bf16_t* so = ST + ((size_t)(bh * 64) << 16) + (32 * jt) * 256 + 32 * it;
    const unsigned so_l = (unsigned)(r32 * 256 + 4 * hi) * 2u;
    const float g64 = __builtin_amdgcn_exp2f(64.0f * lg2gamma(h));
    f32x16 st = zero16();
    bf16x8 a0[4], v0[4], a1[4], v1[4], a2[4], v2[4];
#define SC_LOAD(A, V, c) do { const int c_ = (c) < 62 ? (c) : 62; _Pragma("unroll") for (int ks = 0; ks < 4; ++ks) { A[ks] = ldf(kd + 64 * c_ + 16 * ks, lo); V[ks] = ldf(vv + 64 * c_ + 16 * ks, lo); } } while (0)
#define SC_STORE(c) do { _Pragma("unroll") for (int a = 0; a < 4; ++a) { u32x2 w; w.x = pk2(st[4 * a], st[4 * a + 1]); w.y = pk2(st[4 * a + 2], st[4 * a + 3]); st8(so + ((size_t)(c) << 16) + 8 * a, so_l, w); } } while (0)
#define SC_STEP(A, V, c) do { SC_STORE(c); st = st * g64; _Pragma("unroll") for (int ks = 0; ks < 4; ++ks) st = MFMA32(A[ks], V[ks], st); } while (0)
    SC_LOAD(a0, v0, 0); SC_LOAD(a1, v1, 1);
#pragma unroll 1
    for (int c = 0; c < 63; c += 3) {
        SC_LOAD(a2, v2, c + 2); SC_STEP(a0, v0, c);
        SC_LOAD(a0, v0, c + 3); SC_STEP(a1, v1, c + 1);
        SC_LOAD(a1, v1, c + 4); SC_STEP(a2, v2, c + 2);
    }
    SC_STORE(63);
#undef SC_LOAD
#undef SC_STORE
#undef SC_STEP
}
__device__ __forceinline__ void retc_half(f32x16 (&acc)[4], int hf, bool has_state, const bf16_t* su, unsigned s_l, const bf16_t* hNu, unsigned q_l, float qd,
                                          const bf16_t* vu, unsigned v_l, const bf16x8 p0, const bf16x8 p1, const bf16x8 p2, const bf16x8 p3) {
#pragma unroll
    for (int e = 0; e < 4; ++e) acc[e] = zero16();
    if (has_state) {
#pragma unroll 2
        for (int ks = 0; ks < 16; ++ks) {
            const bf16x8 qf = ldf(hNu + 2048 + 16 * ks, q_l);
#pragma unroll
            for (int e = 0; e < 4; ++e) { const bf16x8 af = ldf(su + (4 * hf + e) * 8192 + 16 * ks, s_l); acc[e] = MFMA32(af, qf, acc[e]); }
            asm volatile("" ::: "memory");
        }
#pragma unroll
        for (int e = 0; e < 4; ++e) acc[e] = acc[e] * qd;
    }
#pragma unroll
    for (int e = 0; e < 4; ++e) {
        const bf16_t* ve = vu + (size_t)(4 * hf + e) * 32 * TOK;
        const bf16x8 v0 = ldf(ve, v_l), v1 = ldf(ve + 16, v_l), v2 = ldf(ve + 32, v_l), v3 = ldf(ve + 48, v_l);
        acc[e] = MFMA32(v0, p0, acc[e]); acc[e] = MFMA32(v1, p1, acc[e]); acc[e] = MFMA32(v2, p2, acc[e]); acc[e] = MFMA32(v3, p3, acc[e]);
        if (e & 1) asm volatile("" ::: "memory");
    }
}
__device__ __forceinline__ void retc_wave(bf16_t* hN, const bf16_t* __restrict__ hT, const bf16_t* __restrict__ ST, const float* __restrict__ gng, const float* __restrict__ gnb, int task, int lane) {
    asm volatile("" : "+v"(lane));
    const int r32 = lane & 31, hi = lane >> 5;
    const int half = task & 1, c = (task >> 1) & 63, bh = task >> 7, h = bh & 3, b = bh >> 2;
    const size_t tok0 = (size_t)b * SEQ + 64 * c;
    const int nl = 32 * half + r32;
    const float lg2 = lg2gamma(h);
    bf16_t* hNu = hN + tok0 * 4096 + h * 256;
    const unsigned q_l = (unsigned)(nl * 4096 + 8 * hi) * 2u;
    const unsigned k_l = (unsigned)(sig32(r32) * 4096 + 8 * hi) * 2u;
    const unsigned g_l = (unsigned)(nl * 4096 + 4 * hi) * 2u;
    bf16x8 p0, p1, p2, p3;
    {
        f32x16 s0 = zero16(), s1 = zero16();
#pragma unroll 2
        for (int ks = 0; ks < 16; ++ks) {
            const bf16x8 qf = ldf(hNu + 2048 + 16 * ks, q_l);
            const bf16x8 k0 = ldf(hNu + 3072 + 16 * ks, k_l), k1 = ldf(hNu + 3072 + 32 * 4096 + 16 * ks, k_l);
            s0 = MFMA32(k0, qf, s0); s1 = MFMA32(k1, qf, s1);
            if ((ks & 1) == 1) asm volatile("" ::: "memory");
        }
#pragma unroll
        for (int i = 0; i < 16; ++i) {
            const int m0 = 16 * (i >> 3) + 8 * hi + (i & 7);
            s0[i] *= __builtin_amdgcn_exp2f(lg2 * fabsf((float)(nl - m0)));
            s1[i] *= __builtin_amdgcn_exp2f(lg2 * fabsf((float)(nl - m0 - 32)));
        }
        p0 = pack_half(s0, 0); p1 = pack_half(s0, 1); p2 = pack_half(s1, 0); p3 = pack_half(s1, 1);
    }
    const bf16_t* su = ST + ((size_t)(bh * 64 + c) << 16);
    const unsigned s_l = (unsigned)(r32 * 256 + 8 * hi) * 2u;
    const float qd = __builtin_amdgcn_exp2f(lg2 * (float)(nl + 1));
    const bf16_t* vu = hT + (size_t)(1024 + h * 256) * TOK + tok0;
    const unsigned v_l = (unsigned)(r32 * TOK + 8 * hi) * 2u;
    float s = 0.f, q = 0.f;
    unsigned pa[32];
    {
        f32x16 acc[4];
        retc_half(acc, 0, c > 0, su, s_l, hNu, q_l, qd, vu, v_l, p0, p1, p2, p3);
#pragma unroll
        for (int e = 0; e < 4; ++e)
#pragma unroll
            for (int i = 0; i < 16; i += 2) { const float x0 = acc[e][i], x1 = acc[e][i + 1]; s += x0 + x1; q += x0 * x0 + x1 * x1; pa[8 * e + (i >> 1)] = pk2(x0, x1); }
    }
    f32x16 acc[4];
    retc_half(acc, 1, c > 0, su, s_l, hNu, q_l, qd, vu, v_l, p0, p1, p2, p3);
#pragma unroll
    for (int e = 0; e < 4; ++e)
#pragma unroll
        for (int i = 0; i < 16; ++i) { s += acc[e][i]; q += acc[e][i] * acc[e][i]; }
    s += shx(s, 32, lane); q += shx(q, 32, lane);
    const float mu = s * (1.0f / 256.0f);
    const float rstd = rsqrtf(fmaxf(q * (1.0f / 256.0f) - mu * mu, 0.f) + 1e-5f);
    const float* gg = gng + h * 256 + 4 * hi; const float* gb = gnb + h * 256 + 4 * hi;
#pragma unroll
    for (int e = 0; e < 8; ++e)
#pragma unroll
        for (int a = 0; a < 4; ++a) {
            const int e0 = 32 * e + 8 * a;
            const f32x4 g4 = *(const f32x4*)(gg + e0), b4 = *(const f32x4*)(gb + e0);
            const u32x2 rw = ld8(hNu + 1024 + e0, g_l);
            const float r0 = bf_lo(rw.x), r1 = bf_hi(rw.x), r2 = bf_lo(rw.y), r3 = bf_hi(rw.y);
            float x[4];
            if (e < 4) { const unsigned w0 = pa[8 * e + 2 * a], w1 = pa[8 * e + 2 * a + 1]; x[0] = bf_lo(w0); x[1] = bf_hi(w0); x[2] = bf_lo(w1); x[3] = bf_hi(w1); }
            else { x[0] = acc[e & 3][4 * a]; x[1] = acc[e & 3][4 * a + 1]; x[2] = acc[e & 3][4 * a + 2]; x[3] = acc[e & 3][4 * a + 3]; }
            float y[4];
#pragma unroll
            for (int j = 0; j < 4; ++j) y[j] = (x[j] - mu) * rstd * g4[j] + b4[j];
            y[0] *= r0 * __builtin_amdgcn_rcpf(1.0f + __builtin_amdgcn_exp2f(-1.4426950408889634f * r0));
            y[1] *= r1 * __builtin_amdgcn_rcpf(1.0f + __builtin_amdgcn_exp2f(-1.4426950408889634f * r1));
            y[2] *= r2 * __builtin_amdgcn_rcpf(1.0f + __builtin_amdgcn_exp2f(-1.4426950408889634f * r2));
            y[3] *= r3 * __builtin_amdgcn_rcpf(1.0f + __builtin_amdgcn_exp2f(-1.4426950408889634f * r3));
            u32x2 w; w.x = pk2(y[0], y[1]); w.y = pk2(y[2], y[3]);
            st8(hNu + 1024 + e0, g_l, w);
            if (a & 1) asm volatile("" ::: "memory");
        }
}
constexpr int ATT_KBYTES = 64 * 384, ATT_VBYTES = 128 * 128, ATT_BUF = ATT_KBYTES + ATT_VBYTES;
__device__ __forceinline__ void attn_unit(LAS unsigned char* lds, const bf16_t* __restrict__ Q, const bf16_t* __restrict__ Kn, const bf16_t* __restrict__ KR, const bf16_t* __restrict__ VT, bf16_t* O, int b, int h, int qb8) {
    int tid = threadIdx.x; asm volatile("" : "+v"(tid));
    const int lane = tid & 63, wave = __builtin_amdgcn_readfirstlane(tid >> 6), r32 = lane & 31, hi = lane >> 5;
    const int qg = 8 * qb8 + wave;
    const size_t n0 = (size_t)b * SEQ + 32 * qg;
    bf16x8 qf[12];
    { const bf16_t* qu = Q + n0 * 1536 + h * 192; const unsigned q_l = (unsigned)(r32 * 1536 + 8 * hi) * 2u;
#pragma unroll
      for (int ks = 0; ks < 12; ++ks) qf[ks] = ldf(qu + 16 * ks, q_l); }
    const int kr0 = tid >> 4, kc0 = tid & 15, rr = tid >> 3, rc = tid & 7;
    const unsigned kst = (unsigned)(kr0 * 384 + (((kc0 & 8) | ((kc0 ^ (kr0 >> 1)) & 7)) << 4));
    const unsigned rst = (unsigned)(rr * 384 + ((16 | ((rc ^ (rr >> 1)) & 7)) << 4));
    const unsigned vst = (unsigned)(ATT_KBYTES + rr * 128 + (((rc ^ (rr >> 1)) & 7) << 4));
    const unsigned gk = (unsigned)(kr0 * 1024 + kc0 * 8) * 2u, gr = (unsigned)(rr * 64 + rc * 8) * 2u, gv = (unsigned)(rr * TOK + rc * 8) * 2u;
    const bf16_t* ku = Kn + (size_t)b * SEQ * 1024 + h * 128;
    const bf16_t* ru = KR + (size_t)b * SEQ * 64;
    const bf16_t* vu = VT + (size_t)h * 128 * TOK + (size_t)b * SEQ;
    const int sg = sig32(r32), sk = (sg >> 1) & 7, sv = (r32 >> 1) & 7;
    unsigned koff[4], voff[4];
#pragma unroll
    for (int k2 = 0; k2 < 4; ++k2) {
        koff[k2] = (unsigned)(sg * 384 + ((((2 * k2) ^ (sk & 6)) | (hi ^ (sk & 1))) << 4));
        voff[k2] = (unsigned)(ATT_KBYTES + r32 * 128 + ((((2 * k2) ^ (sv & 6)) | (hi ^ (sv & 1))) << 4));
    }
    f32x16 o[4];
#pragma unroll
    for (int d = 0; d < 4; ++d) o[d] = zero16();
    float mrun = -1e30f, l = 0.f;
    const int nt_blk = 4 * qb8 + 4, nt_w = (qg >> 1) + 1;
    bf16x8 g0, g1, g2, g3, g4;
#define ATT_GLOAD(kt) do { const bf16_t* k0_ = ku + (size_t)(kt) * 64 * 1024; g0 = ldf(k0_, gk); g1 = ldf(k0_ + 32 * 1024, gk); g2 = ldf(ru + (size_t)(kt) * 64 * 64, gr); \
        const bf16_t* v0_ = vu + (kt) * 64; g3 = ldf(v0_, gv); g4 = ldf(v0_ + (size_t)64 * TOK, gv); } while (0)
#define ATT_LWRITE(bufo) do { LAS unsigned char* p_ = lds + (bufo); *(LAS bf16x8*)(p_ + kst) = g0; *(LAS bf16x8*)(p_ + kst + 32 * 384) = g1; *(LAS bf16x8*)(p_ + rst) = g2; \
        *(LAS bf16x8*)(p_ + vst) = g3; *(LAS bf16x8*)(p_ + vst + 64 * 128) = g4; } while (0)
    ATT_GLOAD(0);
    ATT_LWRITE(0);
    __syncthreads();
    for (int kt = 0; kt < nt_blk; ++kt) {
        const bool more = kt + 1 < nt_blk;
        if (more) ATT_GLOAD(kt + 1);
        if (kt < nt_w) {
            const LAS unsigned char* bp = lds + (kt & 1) * ATT_BUF;
            f32x16 s0 = zero16(), s1 = zero16();
#pragma unroll
            for (int ks = 0; ks < 12; ++ks) {
                const bf16x8 a0 = *(const LAS bf16x8*)(bp + koff[ks & 3] + (ks >> 2) * 128), a1 = *(const LAS bf16x8*)(bp + koff[ks & 3] + (ks >> 2) * 128 + 32 * 384);
                s0 = MFMA32(a0, qf[ks], s0); s1 = MFMA32(a1, qf[ks], s1);
            }
            float mx = fmaxf(s0[0], s1[0]);
#pragma unroll
            for (int i = 1; i < 16; ++i) mx = fmaxf(mx, fmaxf(s0[i], s1[i]));
            mx = fmaxf(mx, shx(mx, 32, lane));
            const float mn = fmaxf(mrun, mx), al = __builtin_amdgcn_exp2f(mrun - mn); mrun = mn;
            float ps = 0.f;
#pragma unroll
            for (int i = 0; i < 16; ++i) { s0[i] = __builtin_amdgcn_exp2f(s0[i] - mn); s1[i] = __builtin_amdgcn_exp2f(s1[i] - mn); ps += s0[i] + s1[i]; }
            l = l * al + ps;
#pragma unroll
            for (int d = 0; d < 4; ++d) o[d] = o[d] * al;
            const bf16x8 p0 = pack_half(s0, 0), p1 = pack_half(s0, 1), p2 = pack_half(s1, 0), p3 = pack_half(s1, 1);
#pragma unroll
            for (int d = 0; d < 4; ++d) {
                const bf16x8 f0 = *(const LAS bf16x8*)(bp + voff[0] + d * 4096), f1 = *(const LAS bf16x8*)(bp + voff[1] + d * 4096),
                             f2 = *(const LAS bf16x8*)(bp + voff[2] + d * 4096), f3 = *(const LAS bf16x8*)(bp + voff[3] + d * 4096);
                o[d] = MFMA32(f0, p0, o[d]); o[d] = MFMA32(f1, p1, o[d]); o[d] = MFMA32(f2, p2, o[d]); o[d] = MFMA32(f3, p3, o[d]);
            }
        }
        if (more) ATT_LWRITE(((kt + 1) & 1) * ATT_BUF);
        __syncthreads();
    }
#undef ATT_GLOAD
#undef ATT_LWRITE
    l += shx(l, 32, lane);
    const float inv = 1.0f / l;
    bf16_t* ou = O + n0 * 4096 + h * 128; const unsigned o_l = (unsigned)(r32 * 4096 + 4 * hi) * 2u;
#pragma unroll
    for (int d = 0; d < 4; ++d)
#pragma unroll
        for (int a = 0; a < 4; ++a) {
            u32x2 w; w.x = pk2(o[d][4 * a] * inv, o[d][4 * a + 1] * inv); w.y = pk2(o[d][4 * a + 2] * inv, o[d][4 * a + 3] * inv);
            st8(ou + 32 * d + 8 * a, o_l, w);
        }
}
typedef __attribute__((address_space(4))) const char* kptr_t;
template <class T> __device__ __forceinline__ T* karg(kptr_t kp, int off) { typedef __attribute__((address_space(1))) T* Gp; return (T*)(*(const __attribute__((address_space(4))) Gp*)(kp + off)); }
struct Args { const float* in[19]; float* out; unsigned char* ws; int ph_lo, ph_hi; };

__global__ void __launch_bounds__(512, 2) mk_fwd(Args a) {
    extern __shared__ __attribute__((aligned(16))) unsigned char lds_raw[];
    LAS unsigned char* lds = (LAS unsigned char*)lds_raw;
    LAS unsigned char* lds_raw_las = lds;
    cg::this_grid().sync();
    if (threadIdx.x < 4) ((volatile LAS unsigned*)(lds_raw_las + 131072))[threadIdx.x] = 0u;
    __syncthreads();
    XcdBarrier bar = xcd_barrier_post((unsigned*)(a.ws + WS_BAR), (volatile LAS unsigned*)(lds_raw_las + 131072));
        const int G = gridDim.x, bx0 = blockIdx.x;
    const int NGW = G * 8;
    const int NTH = G * 512;
    const kptr_t kp0 = (kptr_t)__builtin_amdgcn_kernarg_segment_ptr();
#define KARG(T, off) (karg<T>(kp, (off)))
#define IN(i) KARG(const float, 8 * (i))
#define x_in IN(0)
#define positions ((const int*)IN(1))
#define xres KARG(float, 152)
#define ssb ((float*)(ws + WS_SS))
#define Win_t ((bf16_t*)(ws + WS_WIN))
#define Wuq_t ((bf16_t*)(ws + WS_WUQ))
#define Wkv_t ((bf16_t*)(ws + WS_WKV))
#define Wout_t ((bf16_t*)(ws + WS_WOUT))
#define Wgu_t ((bf16_t*)(ws + WS_WGU))
#define Wd_t ((bf16_t*)(ws + WS_WD))
#define cosT ((float*)(ws + WS_TAB))
#define sinT ((float*)(ws + WS_TAB) + (size_t)TOK * 128)
#define hN ((bf16_t*)(ws + WS_HN))
#define hT ((bf16_t*)(ws + WS_HT))
#define xb ((bf16_t*)(ws + WS_XB))
#define Qb ((bf16_t*)(ws + WS_Q))
#define KR ((bf16_t*)(ws + WS_KR))
#define ST ((bf16_t*)(ws + WS_ST))
#define Kn ((bf16_t*)(ws + WS_KN))
#define VT ((bf16_t*)(ws + WS_VT))
#define act ((bf16_t*)(ws + WS_ACT))
    int ph = 0;
#define PH_BEGIN if (a.ph_lo <= ph && ph < a.ph_hi) { kptr_t kp = kp0; asm volatile("" : "+s"(kp)); unsigned char* const ws = KARG(unsigned char, 160); int bx = bx0; asm volatile("" : "+s"(bx));
#define IDS int tid_ = threadIdx.x; asm volatile("" : "+v"(tid_)); const int lane = tid_ & 63; const int wave = __builtin_amdgcn_readfirstlane(tid_ >> 6); const int gw = wave * G + bx; LAS float* scr = (LAS float*)(lds + wave * 16384); const int gtid = bx * 512 + wave * 64 + lane; (void)scr; (void)gtid; (void)gw;
#define PH_END   if (ph + 1 < a.ph_hi) { XcdBarrier b2 = bar; asm volatile("" : "+s"(b2.bar)); xcd_barrier(b2); } } ++ph;

#define CVT_ATTN(l) do { \
        const float* w_in_l = IN(4) + (size_t)(l) * 2048 * 4928; const float* w_uq_l = IN(7) + (size_t)(l) * 512 * 1536; \
        const float* w_ukv_l = IN(8) + (size_t)(l) * 256 * 2048; const float* w_out_l = IN(11) + (size_t)(l) * 2048 * 2048; \
        const float* qng = IN(5) + (l) * 512; const float* kvng = IN(6) + (l) * 256; \
        for (int it = gw; it < 7616; it += NGW) { int r = it; \
            if (r < 4928) { cvt_item<0>(w_in_l, 2048, 4928, nullptr, Win_t, scr, r, lane); continue; } r -= 4928; \
            if (r < 384) { cvt_item<1>(w_uq_l, 512, 1536, qng, Wuq_t, scr, r, lane); continue; } r -= 384; \
            if (r < 256) { cvt_item<2>(w_ukv_l, 256, 2048, kvng, Wkv_t, scr, r, lane); continue; } r -= 256; \
            cvt_item<3>(w_out_l, 2048, 2048, nullptr, Wout_t, scr, r, lane); } \
        for (int i = gtid; i < 192 * 256; i += NTH) { const int rr = i >> 8, cc = i & 255; const int row = rr < 96 ? 800 + rr : 928 + (rr - 96); \
            unsigned z = 0u; asm volatile("" : "+v"(z)); *(u32x4*)(Win_t + (size_t)row * 2048 + cc * 8) = (u32x4){z, z, z, z}; } \
    } while (0)
#define CVT_FFN(l) do { \
        const float* w_g = IN(14) + (size_t)(l) * 2048 * 5632; const float* w_u = IN(15) + (size_t)(l) * 2048 * 5632; const float* w_d = IN(16) + (size_t)(l) * 5632 * 2048; \
        for (int it = gw; it < 3 * 5632; it += NGW) { int r = it; \
            if (r < 5632) { cvt_item<4>(w_g, 2048, 5632, nullptr, Wgu_t, scr, r, lane); continue; } r -= 5632; \
            if (r < 5632) { cvt_item<5>(w_u, 2048, 5632, nullptr, Wgu_t, scr, r, lane); continue; } r -= 5632; \
            cvt_item<3>(w_d, 5632, 2048, nullptr, Wd_t, scr, r, lane); } \
    } while (0)

    PH_BEGIN
        IDS
        for (int idx = gtid; idx < TOK * 128; idx += NTH) {
            const int t = idx >> 7, j = idx & 127;
            const float invf = __builtin_amdgcn_exp2f(-(float)j * (13.287712379549449f / 128.0f));
            const double rev = (double)positions[t] * (double)invf * 0.15915494309189535;
            const float fr = (float)(rev - __builtin_rint(rev));
            cosT[idx] = __builtin_amdgcn_cosf(fr); sinT[idx] = __builtin_amdgcn_sinf(fr);
        }
        for (int i = gtid; i < 4 * TOK; i += NTH) ssb[i] = 0.f;
#ifndef DIS_CVT
        CVT_ATTN(0);
#endif
#ifndef DIS_LN
        for (int m = gw; m < TOK; m += NGW) ln_row(x_in + (size_t)m * DM, xres + (size_t)m * DM, xb + (size_t)m * DM, IN(2), IN(3), lane);
#endif
    PH_END

    for (int l = 0; l < 2; ++l) {

        PH_BEGIN
            float* ssq = ssb + (size_t)l * 2 * TOK; float* sskv = ssq + TOK;
#ifndef DIS_G1
            { pg8::Gemm g{xb, Win_t, TOK, 4096, 2048, 2048, 2048}; pg8::StaticOrder S; S.init(TOK, 4096, G, bx);
              pg8::EpiIn E{hN, KR, ssq, sskv, cosT, sinT};
              pg8::gemm_phase<pg8::EpiIn, pg8::StaticOrder, PG8_ALIGN, PG8_SP2>(lds, g, S, E); }
#endif
#ifndef DIS_G2
            { pg8::Gemm g{Win_t + (size_t)4096 * 2048, xb, 2048, TOK, 2048, 2048, 2048}; pg8::StaticOrder S; S.init(2048, TOK, G, bx);
              pg8::EpiInT E{hT, cosT, sinT};
              pg8::gemm_phase<pg8::EpiInT, pg8::StaticOrder, PG8_ALIGN, PG8_SP2>(lds, g, S, E); }
#endif
        PH_END
        PH_BEGIN
            float* ssq = ssb + (size_t)l * 2 * TOK; float* sskv = ssq + TOK;
#ifndef DIS_G3
            { pg8::Gemm g{hN, Wuq_t, TOK, 1536, 512, 4096, 512}; pg8::StaticOrder S; S.init(TOK, 1536, G, bx);
              pg8::EpiQ E{Qb, ssq, cosT, sinT};
              pg8::gemm_phase<pg8::EpiQ, pg8::StaticOrder, PG8_ALIGN, PG8_SP2>(lds, g, S, E); }
#endif
#ifndef DIS_G4
            { pg8::Gemm g{hN + 512, Wkv_t, TOK, 1024, 256, 4096, 256}; pg8::StaticOrder S; S.init(TOK, 1024, G, bx);
              pg8::EpiK E{Kn, sskv};
              pg8::gemm_phase<pg8::EpiK, pg8::StaticOrder, PG8_ALIGN, PG8_SP2>(lds, g, S, E); }
#endif
#ifndef DIS_G5
            { pg8::Gemm g{Wkv_t + (size_t)1024 * 256, hN + 512, 1024, TOK, 256, 256, 4096}; pg8::StaticOrder S; S.init(1024, TOK, G, bx);
              pg8::EpiVT E{VT, sskv};
              pg8::gemm_phase<pg8::EpiVT, pg8::StaticOrder, PG8_ALIGN, PG8_SP2>(lds, g, S, E); }
#endif
#ifndef DIS_SCAN
            { IDS
            for (int wt = gw; wt < 1024; wt += NGW) scan_wave(hT, ST, wt, lane); }
#endif
        PH_END
        PH_BEGIN
            IDS
            for (int bt = bx; bt < 512; bt += G) {
                const int b2 = bt & 255, xcd = b2 & 7, y = b2 >> 3, bh = xcd * 4 + (y >> 3), q8 = y & 7;
                const int qb8 = bt < 256 ? q8 : 15 - q8;
#ifndef DIS_ATTN
                attn_unit(lds, Qb, Kn, KR, VT, hN, bh >> 3, bh & 7, qb8);
#endif
            }
#ifndef DIS_RETC
            for (int task = bx * 8 + wave; task < 2048; task += NGW) retc_wave(hN, hT, ST, IN(9) + l * 1024, IN(10) + l * 1024, task, lane);
#endif
        PH_END
        PH_BEGIN
#ifndef DIS_G6
            { pg8::Gemm g{hN, Wout_t, TOK, 2048, 2048, 4096, 2048}; pg8::StaticOrder S; S.init(TOK, 2048, G, bx);
              pg8::EpiRes E{xres};
              pg8::gemm_phase<pg8::EpiRes, pg8::StaticOrder, PG8_ALIGN, PG8_SP2>(lds, g, S, E); }
#endif
        PH_END
        PH_BEGIN
            IDS
#ifndef DIS_LN
            for (int m = gw; m < TOK; m += NGW) ln_row(xres + (size_t)m * DM, xres + (size_t)m * DM, xb + (size_t)m * DM, IN(12) + l * DM, IN(13) + l * DM, lane);
#endif
#ifndef DIS_CVT
            CVT_FFN(l);
#endif
        PH_END
        PH_BEGIN
#ifndef DIS_G7
            { pg8::Gemm g{xb, Wgu_t, TOK, 2 * DFF, 2048, 2048, 2048}; pg8::StaticOrder S; S.init(TOK, 2 * DFF, G, bx);
              pg8::EpiGU E{act};
              pg8::gemm_phase<pg8::EpiGU, pg8::StaticOrder, PG8_ALIGN, PG8_SP2>(lds, g, S, E); }
#endif
        PH_END
        PH_BEGIN
#ifndef DIS_G8
            { pg8::Gemm g{act, Wd_t, TOK, 2048, DFF, DFF, DFF}; pg8::StaticOrder S; S.init(TOK, 2048, G, bx);
              pg8::EpiRes E{xres};
              pg8::gemm_phase<pg8::EpiRes, pg8::StaticOrder, PG8_ALIGN, PG8_SP2>(lds, g, S, E); }
#endif
        PH_END
        PH_BEGIN
            IDS
#ifndef DIS_LN
            for (int m = gw; m < TOK; m += NGW) ln_row(xres + (size_t)m * DM, xres + (size_t)m * DM, xb + (size_t)m * DM, IN(17) + l * DM, IN(18) + l * DM, lane);
#endif
#ifndef DIS_CVT
            if (l == 0) CVT_ATTN(1);
#endif
        PH_END
    }
}

#undef IN
#undef KARG
#undef x_in
#undef positions
#undef xres
#undef ssb
#undef Win_t
#undef Wuq_t
#undef Wkv_t
#undef Wout_t
#undef Wgu_t
#undef Wd_t
#undef cosT
#undef sinT
#undef hN
#undef hT
#undef xb
#undef Qb
#undef KR
#undef ST
#undef Kn
#undef VT
#undef act
#ifndef MK_SPLIT
#define MK_SPLIT 0
#endif
extern "C" void kernel_launch(void* const* d_in, const int* in_sizes, int n_in, void* d_out, int out_size, void* d_ws, size_t ws_size, hipStream_t stream) {
    static int grid = 0;
    if (grid == 0) {
        if (n_in != 19 || out_size != TOK * DM || ws_size < WS_END) { fprintf(stderr, "kernel_launch: unexpected shapes (n_in %d, out %d, ws %zu)\n", n_in, out_size, ws_size); grid = -1; return; }
        int dev = 0, cus = 0, per_cu = 0;
        (void)hipGetDevice(&dev); (void)hipDeviceGetAttribute(&cus, hipDeviceAttributeMultiprocessorCount, dev);
        if (hipFuncSetAttribute((const void*)mk_fwd, hipFuncAttributeMaxDynamicSharedMemorySize, LDS_BYTES) != hipSuccess) { fprintf(stderr, "kernel_launch: hipFuncSetAttribute failed\n"); grid = -1; return; }
        if (hipOccupancyMaxActiveBlocksPerMultiprocessor(&per_cu, (const void*)mk_fwd, 512, LDS_BYTES) != hipSuccess || per_cu < 1) { fprintf(stderr, "kernel_launch: occupancy query says %d\n", per_cu); per_cu = 1; }
        (void)hipGetLastError();
        grid = cus * 1;
        if (grid <= 0) grid = 256;
    }
    if (grid < 0) return;
    if (hipMemsetAsync((char*)d_ws + WS_BAR, 0, XCD_BAR_WORDS * 4, stream) != hipSuccess) { fprintf(stderr, "kernel_launch: memset failed\n"); return; }
    Args a{};
    for (int i = 0; i < 19; ++i) a.in[i] = (const float*)d_in[i];
    a.out = (float*)d_out; a.ws = (unsigned char*)d_ws;
#if MK_SPLIT
    for (int p = 0; p < NPH; ++p) { a.ph_lo = p; a.ph_hi = p + 1; void* args[] = {&a};
        hipError_t e = hipLaunchCooperativeKernel((const void*)mk_fwd, dim3(grid), dim3(512), args, LDS_BYTES, stream);
        if (e != hipSuccess) { fprintf(stderr, "launch %d failed: %s\n", p, hipGetErrorString(e)); break; } }
#else
    a.ph_lo = 0; a.ph_hi = NPH; void* args[] = {&a};
    hipError_t e = hipLaunchCooperativeKernel((const void*)mk_fwd, dim3(grid), dim3(512), args, LDS_BYTES, stream);
    if (e != hipSuccess) fprintf(stderr, "cooperative launch failed: %s (grid %d)\n", hipGetErrorString(e), grid);
#endif
}
```
